# Optimizing an MI355X kernel written in HIP

```python
import math
import jax, jax.numpy as jnp
from jax import lax
import numpy as np

D_MODEL = 1024
BATCH = 1
SEQ = 16384
DEPTH = 1
DEC_BATCH = 8
DEC_SEQ = 4096
PAST_LEN = 128

GLA_HEADS = 4
GLA_DK = D_MODEL // 2
GLA_DV = D_MODEL
GLA_HK = GLA_DK // GLA_HEADS
GLA_HV = GLA_DV // GLA_HEADS
GLA_RANK = 16
GLA_LOGIT_NORM = 16.0
GLA_CHUNK = 64
DIFF_HEAD_DIM = 64
DIFF_HEADS = D_MODEL // (2 * DIFF_HEAD_DIM)
DIFF_QK = DIFF_HEADS * 2 * DIFF_HEAD_DIM
DIFF_DV = DIFF_HEADS * 2 * DIFF_HEAD_DIM
ROPE_THETA = 10000.0
Q_BLOCK = 128
EPS = 1e-6

SPLIT_SIZES = (GLA_DK, GLA_DK, GLA_DV, GLA_DV, 2 * GLA_RANK,
               DIFF_QK, DIFF_QK, DIFF_DV, DIFF_DV, D_MODEL, D_MODEL)
IN_COLS = sum(SPLIT_SIZES)

kernel_name = "hybrid_gla_diffattn_encoder"


def rms_norm(x, gain):
    xf = x.astype(jnp.float32)
    y = xf * lax.rsqrt(jnp.mean(xf * xf, axis=-1, keepdims=True) + EPS)
    return y.astype(x.dtype) * gain


def rope(x):
    L, d = x.shape[1], x.shape[-1]
    half = d // 2
    inv = 1.0 / (ROPE_THETA ** (jnp.arange(half, dtype=jnp.float32) / half))
    ang = jnp.arange(L, dtype=jnp.float32)[:, None] * inv[None, :]
    cos = jnp.cos(ang)[None, :, None, None, :]
    sin = jnp.sin(ang)[None, :, None, None, :]
    xf = x.astype(jnp.float32)
    x1, x2 = xf[..., :half], xf[..., half:]
    out = jnp.concatenate([x1 * cos - x2 * sin, x1 * sin + x2 * cos], axis=-1)
    return out.astype(x.dtype)


def gla_chunk_step(state, inp):
    q, k, v, g = inp
    C = q.shape[-2]
    b = jnp.cumsum(g, axis=-2)
    o_inter = jnp.einsum('zbhcd,zbhde->zbhce', q * jnp.exp(b), state)
    causal = jnp.tril(jnp.ones((C, C), dtype=bool))
    rel = b[..., :, None, :] - b[..., None, :, :]
    decay = jnp.exp(jnp.where(causal[:, :, None], rel, -jnp.inf))
    scores = jnp.einsum('zbhid,zbhjd,zbhijd->zbhij', q, k, decay)
    o = o_inter + jnp.einsum('zbhij,zbhje->zbhie', scores, v)
    b_last = b[..., -1:, :]
    state = (jnp.exp(b_last[..., 0, :])[..., None] * state
             + jnp.einsum('zbhcd,zbhce->zbhde', k * jnp.exp(b_last - b), v))
    return state, o


def bidirectional_gla(q, k, v, g_fwd, g_bwd):
    B, L, H, dk = q.shape
    dv = v.shape[-1]
    n = L // GLA_CHUNK
    flip = lambda t: jnp.flip(t, axis=1)

    def to_chunks(fwd, bwd):
        t = jnp.stack([fwd, bwd], axis=0).astype(jnp.float32)
        t = t.reshape(2, B, n, GLA_CHUNK, H, t.shape[-1])
        return t.transpose(2, 0, 1, 4, 3, 5)

    xs = (to_chunks(q, flip(q)), to_chunks(k, flip(k)),
          to_chunks(v, flip(v)), to_chunks(g_fwd, flip(g_bwd)))
    state0 = jnp.zeros((2, B, H, dk, dv), jnp.float32)
    _, o = lax.scan(gla_chunk_step, state0, xs)
    o = o.transpose(1, 2, 0, 4, 3, 5).reshape(2, B, L, H, dv)
    return (o[0] + flip(o[1])).astype(v.dtype)


def diff_attention(q, k, v, lam):
    B, L, H, _, d = q.shape
    nb = L // Q_BLOCK
    scale = d ** -0.5
    qb = q.reshape(B, nb, Q_BLOCK, H, 2, d).transpose(1, 0, 2, 3, 4, 5)

    def block(qblk):
        s = jnp.einsum('bqhzd,bkhzd->bhzqk', qblk, k,
                       preferred_element_type=jnp.float32) * scale
        p = jax.nn.softmax(s, axis=-1)
        p = p[:, :, 0] - lam * p[:, :, 1]
        return jnp.einsum('bhqk,bkhe->bqhe', p.astype(v.dtype), v)

    o = lax.map(block, qb)
    return o.transpose(1, 0, 2, 3, 4).reshape(B, L, H, 2 * d)


def encoder_layer(x, c, lam_init, w_ada, b_ada, norm_gain, w_in, w_alpha, b_alpha,
                  gla_norm_gain, lambda_q, lambda_k, diff_norm_gain,
                  w_bo_gla, w_bo_diff, w_out):
    B, L, _ = x.shape
    mod = jax.nn.silu(c) @ w_ada + b_ada
    shift, scale, gate = jnp.split(mod, 3, axis=-1)
    h = rms_norm(x, norm_gain) * (1.0 + scale[:, None, :]) + shift[:, None, :]

    proj = h @ w_in
    points = np.cumsum(SPLIT_SIZES)[:-1].tolist()
    (a_q, a_k, a_v, a_z, a_low, d_q, d_k, d_v, d_z, m_gla, m_diff) = jnp.split(proj, points, axis=-1)

    q = (a_q * (GLA_HK ** -0.5)).reshape(B, L, GLA_HEADS, GLA_HK)
    k = a_k.reshape(B, L, GLA_HEADS, GLA_HK)
    v = a_v.reshape(B, L, GLA_HEADS, GLA_HV)
    low = a_low.reshape(B, L, 2, GLA_RANK)
    logits = jnp.einsum('blzr,zrk->blzk', low, w_alpha) + b_alpha
    log_alpha = jax.nn.log_sigmoid(logits.astype(jnp.float32)) / GLA_LOGIT_NORM
    g_fwd = log_alpha[:, :, 0].reshape(B, L, GLA_HEADS, GLA_HK)
    g_bwd = log_alpha[:, :, 1].reshape(B, L, GLA_HEADS, GLA_HK)
    o_gla = bidirectional_gla(q, k, v, g_fwd, g_bwd)
    o_gla = rms_norm(o_gla, gla_norm_gain).reshape(B, L, GLA_DV) * jax.nn.silu(a_z)
    y_gla = o_gla @ w_bo_gla

    lq = lambda_q.astype(jnp.float32)
    lk = lambda_k.astype(jnp.float32)
    lam = jnp.exp(jnp.sum(lq[0] * lk[0])) - jnp.exp(jnp.sum(lq[1] * lk[1])) + lam_init
    dq = rope(d_q.reshape(B, L, DIFF_HEADS, 2, DIFF_HEAD_DIM))
    dk = rope(d_k.reshape(B, L, DIFF_HEADS, 2, DIFF_HEAD_DIM))
    dv = d_v.reshape(B, L, DIFF_HEADS, 2 * DIFF_HEAD_DIM)
    o_diff = diff_attention(dq, dk, dv, lam)
    o_diff = rms_norm(o_diff, diff_norm_gain) * (1.0 - lam_init)
    o_diff = o_diff.reshape(B, L, DIFF_DV) * jax.nn.silu(d_z)
    y_diff = o_diff @ w_bo_diff

    merged = jax.nn.sigmoid(m_gla) * y_gla + jax.nn.sigmoid(m_diff) * y_diff
    return x + gate[:, None, :] * (merged @ w_out)


def setup_inputs(seed: int = 0) -> dict:
    key = jax.random.key(seed)
    ks = jax.random.split(key, 20)
    f32 = jnp.float32
    nrm = lambda k, shape, s: jax.random.normal(k, shape, f32) * s
    return {
        "x_prompt": nrm(ks[0], (BATCH, SEQ, D_MODEL), 1.0),
        "x_sample": nrm(ks[1], (DEC_BATCH, DEC_SEQ, D_MODEL), 1.0),
        "c_prompt": nrm(ks[2], (BATCH, D_MODEL), 1.0),
        "c_sample": nrm(ks[3], (DEC_BATCH, D_MODEL), 1.0),
        "w_ada": nrm(ks[4], (DEPTH, D_MODEL, 3 * D_MODEL), D_MODEL ** -0.5),
        "b_ada": nrm(ks[5], (DEPTH, 3 * D_MODEL), 0.01),
        "norm_gain": 1.0 + nrm(ks[6], (DEPTH, D_MODEL), 0.01),
        "w_in": nrm(ks[7], (DEPTH, D_MODEL, IN_COLS), D_MODEL ** -0.5),
        "w_alpha": nrm(ks[8], (DEPTH, 2, GLA_RANK, GLA_DK), GLA_RANK ** -0.5),
        "b_alpha": nrm(ks[9], (DEPTH, 2, GLA_DK), 0.1),
        "gla_norm_gain": 1.0 + nrm(ks[10], (DEPTH, GLA_HV), 0.01),
        "lambda_q": nrm(ks[11], (DEPTH, 2, DIFF_HEAD_DIM), 0.1),
        "lambda_k": nrm(ks[12], (DEPTH, 2, DIFF_HEAD_DIM), 0.1),
        "diff_norm_gain": 1.0 + nrm(ks[13], (DEPTH, 2 * DIFF_HEAD_DIM), 0.01),
        "w_bo_gla": nrm(ks[14], (DEPTH, GLA_DV, D_MODEL), GLA_DV ** -0.5),
        "w_bo_diff": nrm(ks[15], (DEPTH, DIFF_DV, D_MODEL), DIFF_DV ** -0.5),
        "w_out": nrm(ks[16], (DEPTH, D_MODEL, D_MODEL), D_MODEL ** -0.5),
        "final_gain": 1.0 + nrm(ks[17], (D_MODEL,), 0.01),
    }


def reference(x_prompt, x_sample, c_prompt, c_sample, w_ada, b_ada, norm_gain, w_in,
              w_alpha, b_alpha, gla_norm_gain, lambda_q, lambda_k, diff_norm_gain,
              w_bo_gla, w_bo_diff, w_out, final_gain):
    def trunk(x, c):
        for layer in range(DEPTH):
            lam_init = 0.8 - 0.6 * math.exp(-0.3 * layer)
            x = encoder_layer(x, c, lam_init, w_ada[layer], b_ada[layer], norm_gain[layer],
                              w_in[layer], w_alpha[layer], b_alpha[layer],
                              gla_norm_gain[layer], lambda_q[layer], lambda_k[layer],
                              diff_norm_gain[layer], w_bo_gla[layer], w_bo_diff[layer],
                              w_out[layer])
        return rms_norm(x, final_gain)

    y_prompt = trunk(x_prompt, c_prompt)
    y_sample = trunk(x_sample, c_sample)
    return (y_prompt, y_sample)
```

```cpp
#include <hip/hip_runtime.h>
#include <hip/hip_cooperative_groups.h>
#include <cstdio>
#include <cstdint>
namespace cg = cooperative_groups;

#ifndef COOP
#define COOP 1
#endif

typedef unsigned short bf16_t;
using bf16x8 = __attribute__((ext_vector_type(8))) short;
using s16x4  = __attribute__((ext_vector_type(4))) short;
using f32x16 = __attribute__((ext_vector_type(16))) float;
using f32x4  = __attribute__((ext_vector_type(4))) float;
using f32x2  = __attribute__((ext_vector_type(2))) float;
using u32x4  = __attribute__((ext_vector_type(4))) unsigned;
using u32x2  = __attribute__((ext_vector_type(2))) unsigned;

constexpr int DM = 1024, LP = 16384, LS = 4096, NSEQ = 9, NTOK = LP + 8 * LS;
constexpr int INC = 9248;
constexpr int NP1 = 5248;
constexpr int NP3 = 4096;
constexpr float EPS = 1e-6f;

constexpr size_t SZ_HALF = (size_t)NTOK * 512 * 2;
constexpr size_t SZ_FULL = (size_t)NTOK * 1024 * 2;
constexpr size_t OFF_GQ = 0, OFF_GK = OFF_GQ + SZ_HALF, OFF_GV = OFF_GK + SZ_HALF, OFF_DQ = OFF_GV + SZ_FULL, OFF_DK = OFF_DQ + SZ_FULL, OFF_DV = OFF_DK + SZ_FULL;
constexpr size_t OFF_LOW = OFF_DV + SZ_FULL, SZ_LOW = (size_t)NTOK * 32 * 4;
constexpr size_t OFF_WP1 = OFF_LOW + SZ_LOW, OFF_WP3 = OFF_WP1 + (size_t)NP1 * 1024 * 2, OFF_WG = OFF_WP3 + (size_t)NP3 * 1024 * 2;
constexpr size_t OFF_WD = OFF_WG + 2097152, OFF_WO = OFF_WD + 2097152, OFF_MOD = OFF_WO + 2097152;
constexpr size_t OFF_ROPE = OFF_MOD + (size_t)NSEQ * 3072 * 4, OFF_MISC = OFF_ROPE + 65536, WS_NEED = OFF_MISC + 4096;
constexpr size_t OFF_H3 = OFF_GQ, OFF_OGN = OFF_GV, OFF_A2 = OFF_DK, OFF_A3 = OFF_DV, OFF_MRG = OFF_GV;

constexpr int LDS_BYTES = 106 * 1024, NTHR = 512;
__shared__ __attribute__((aligned(16))) char g_lds[LDS_BYTES];
#define NOINL __forceinline__

struct Params {
  const float *x_prompt, *x_sample, *c_prompt, *c_sample, *w_ada, *b_ada, *norm_gain, *w_in, *w_alpha, *b_alpha, *gla_norm_gain, *lambda_q, *lambda_k,
      *diff_norm_gain, *w_bo_gla, *w_bo_diff, *w_out, *final_gain;
  float* out; char* ws;
};

typedef __bf16 bf16n2 __attribute__((ext_vector_type(2)));
__device__ __forceinline__ unsigned cvtpk(float lo, float hi) { const f32x2 v = {lo, hi}; const bf16n2 b = __builtin_convertvector(v, bf16n2); return __builtin_bit_cast(unsigned, b); }
__device__ __forceinline__ bf16_t f2bf(float x) { return (bf16_t)(cvtpk(x, 0.f) & 0xffffu); }
__device__ __forceinline__ float bf2f(bf16_t v) { return __uint_as_float((unsigned)v << 16); }
__device__ __forceinline__ float bflo(unsigned w) { return __uint_as_float(w << 16); }
__device__ __forceinline__ float bfhi(unsigned w) { return __uint_as_float(w & 0xffff0000u); }
__device__ __forceinline__ int crow(int r, int hi) { return (r & 3) + 8 * (r >> 2) + 4 * hi; }
__device__ __forceinline__ float siluf(float x) { return x * __builtin_amdgcn_rcpf(1.f + __expf(-x)); }
__device__ __forceinline__ float sigmf(float x) { return __builtin_amdgcn_rcpf(1.f + __expf(-x)); }
__device__ __forceinline__ int seq_of_row(int row) { return row < LP ? 0 : 1 + ((row - LP) >> 12); }
__device__ __forceinline__ int seq_base(int s) { return s == 0 ? 0 : LP + (s - 1) * LS; }
__device__ __forceinline__ int seq_len(int s) { return s == 0 ? LP : LS; }
__device__ __forceinline__ const float* xrow(const Params& p, int row) { return row < LP ? p.x_prompt + (size_t)row * DM : p.x_sample + (size_t)(row - LP) * DM; }

__device__ void sincos_d(double a, double& s, double& c) {
  const double n = rint(a * 0.63661977236758134308);
  double y = a - n * 1.5707963267341256; y -= n * 6.077100506506192e-11;
  const double y2 = y * y;
  double sp = 1.0 / 355687428096000.0;
  sp = sp * y2 - 1.0 / 1307674368000.0; sp = sp * y2 + 1.0 / 6227020800.0; sp = sp * y2 - 1.0 / 39916800.0; sp = sp * y2 + 1.0 / 362880.0;
  sp = sp * y2 - 1.0 / 5040.0; sp = sp * y2 + 1.0 / 120.0; sp = sp * y2 - 1.0 / 6.0; sp = sp * y2 + 1.0; sp *= y;
  double cp = 1.0 / 20922789888000.0;
  cp = cp * y2 - 1.0 / 87178291200.0; cp = cp * y2 + 1.0 / 479001600.0; cp = cp * y2 - 1.0 / 3628800.0; cp = cp * y2 + 1.0 / 40320.0;
  cp = cp * y2 - 1.0 / 720.0; cp = cp * y2 + 1.0 / 24.0; cp = cp * y2 - 0.5; cp = cp * y2 + 1.0;
  const int q = ((int)n) & 3;
  s = (q == 0) ? sp : (q == 1) ? cp : (q == 2) ? -sp : -cp;
  c = (q == 0) ? cp : (q == 1) ? -sp : (q == 2) ? -cp : sp;
}

constexpr int P0_MOD_TASKS = 192;
constexpr int T_WP1 = NP1 / 64  , T_WP3 = NP3 / 64  , T_SQ = 16;
constexpr int P0_TR_TILES = (T_WP1 + T_WP3 + 3 * T_SQ) * 16;
constexpr int P0_TASKS = P0_MOD_TASKS + P0_TR_TILES + 1 + 16;

__device__ void p0_mod_task(const Params& p, int t, char* lds) {
  float* sc = (float*)lds;
  float* red = (float*)(lds + 36864);
  const int tid = threadIdx.x;
  for (int i = tid; i < NSEQ * 1024; i += NTHR) { const int s = i >> 10, k = i & 1023; const float c = s == 0 ? p.c_prompt[k] : p.c_sample[(s - 1) * 1024 + k]; sc[i] = siluf(c); }
  __syncthreads();
  const int col = tid & 15, kp = tid >> 4, n = t * 16 + col;
  float acc[NSEQ];
#pragma unroll
  for (int s = 0; s < NSEQ; ++s) acc[s] = 0.f;
  for (int kk = 0; kk < 32; ++kk) { const int k = kp * 32 + kk; const float w = p.w_ada[(size_t)k * 3072 + n];
#pragma unroll
    for (int s = 0; s < NSEQ; ++s) acc[s] += sc[s * 1024 + k] * w; }
#pragma unroll
  for (int s = 0; s < NSEQ; ++s) red[(kp * NSEQ + s) * 16 + col] = acc[s];
  __syncthreads();
  if (tid < NSEQ * 16) { const int s = tid >> 4, c2 = tid & 15; float a = p.b_ada[t * 16 + c2];
    for (int q = 0; q < 32; ++q) a += red[(q * NSEQ + s) * 16 + c2];
    ((float*)(p.ws + OFF_MOD))[s * 3072 + t * 16 + c2] = a; }
  __syncthreads();
}

__device__ void p0_tr_tile(const float* src, int ld, int c0, int nvalid, bf16_t* dst, int n0, int k0, char* lds) {
  bf16_t* tile = (bf16_t*)lds;
  const int tid = threadIdx.x, kr = tid >> 4, c4 = (tid & 15) * 4;
#pragma unroll
  for (int i = 0; i < 2; ++i) { const int k = kr + 32 * i; f32x4 v = {0.f, 0.f, 0.f, 0.f};
    if (c4 < nvalid) v = *(const f32x4*)(src + (size_t)(k0 + k) * ld + c0 + c4);
    tile[(c4 + 0) * 72 + k] = f2bf(v[0]); tile[(c4 + 1) * 72 + k] = f2bf(v[1]); tile[(c4 + 2) * 72 + k] = f2bf(v[2]); tile[(c4 + 3) * 72 + k] = f2bf(v[3]); }
  __syncthreads();
  { const int n = tid >> 3, kq = (tid & 7) * 8;
    const u32x4 a = *(const u32x4*)(tile + n * 72 + kq);
    bf16_t* d = dst + (size_t)(n0 + n) * 1024 + k0 + kq; *(u32x4*)d = a; }
  __syncthreads();
}

__device__ NOINL void phase0(const Params& p) {
  char* lds = g_lds;
  for (int t = blockIdx.x; t < P0_TASKS; t += gridDim.x) {
    if (t < P0_MOD_TASKS) { p0_mod_task(p, t, lds); continue; }
    int u = t - P0_MOD_TASKS;
    if (u < P0_TR_TILES) {
      const int kt = u & 15; int ct = u >> 4;
      if (ct < T_WP1) { const int n0 = ct * 64; int c0, nv = 64;
        if (n0 < 2048) c0 = n0; else if (n0 < 5120) c0 = 3104 + (n0 - 2048); else if (n0 < 5184) { c0 = 3072; nv = 32; } else { c0 = 0; nv = 0; }
        p0_tr_tile(p.w_in, INC, c0, nv, (bf16_t*)(p.ws + OFF_WP1), n0, kt * 64, lds); continue; }
      ct -= T_WP1;
      if (ct < T_WP3) { const int n0 = ct * 64; const int c0 = n0 < 1024 ? 2048 + n0 : n0 < 2048 ? 6176 + (n0 - 1024) : 7200 + (n0 - 2048);
        p0_tr_tile(p.w_in, INC, c0, 64, (bf16_t*)(p.ws + OFF_WP3), n0, kt * 64, lds); continue; }
      ct -= T_WP3;
      const int which = ct >> 4, n0 = (ct & 15) * 64;
      const float* src = which == 0 ? p.w_bo_gla : which == 1 ? p.w_bo_diff : p.w_out;
      bf16_t* dst = (bf16_t*)(p.ws + (which == 0 ? OFF_WG : which == 1 ? OFF_WD : OFF_WO));
      p0_tr_tile(src, 1024, n0, 64, dst, n0, kt * 64, lds); continue;
    }
    u -= P0_TR_TILES;
    if (u == 0) {
      if (threadIdx.x == 0) { float a = 0.f, b = 0.f; for (int i = 0; i < 64; ++i) { a += p.lambda_q[i] * p.lambda_k[i]; b += p.lambda_q[64 + i] * p.lambda_k[64 + i]; }
        float* misc = (float*)(p.ws + OFF_MISC); misc[0] = expf(a) - expf(b) + 0.2f; for (int q = 0; q < 8; ++q) ((unsigned*)misc)[64 + q * 32] = 0u; ((unsigned*)misc)[512] = 0u; }
      continue; }
    u -= 1;
    { const int idx = u * NTHR + threadIdx.x, tab = idx >> 12, a = (idx >> 5) & 127, i = idx & 31;
      double inv = 1.0; for (int q = 0; q < i; ++q) inv *= 0.7498942093324558;
      const double ang = (tab == 0 ? 128.0 * (double)a : (double)a) * inv; double s, c; sincos_d(ang, s, c);
      ((f32x2*)(p.ws + OFF_ROPE))[idx] = (f32x2){(float)c, (float)s}; }
  }
}

template <bool WITH_OGN>
__device__ NOINL void phase_h(const Params& p, bf16_t* hdst) {
  const int lane = threadIdx.x & 63, wid = threadIdx.x >> 6;
  const float* mod = (const float*)(p.ws + OFF_MOD);
  int scur = -1; f32x4 ca[4], cb[4];
  f32x4 gg0 = {0.f, 0.f, 0.f, 0.f}, gg1 = gg0;
  if constexpr (WITH_OGN) { gg0 = *(const f32x4*)(p.gla_norm_gain + ((lane * 8) & 255)); gg1 = *(const f32x4*)(p.gla_norm_gain + ((lane * 8) & 255) + 4); }
  for (int row = blockIdx.x * 8 + wid; row < NTOK; row += gridDim.x * 8) {
    const float* x = xrow(p, row); const int s = seq_of_row(row);
    f32x4 v[4]; float ss = 0.f;
#pragma unroll
    for (int i = 0; i < 4; ++i) { v[i] = __builtin_nontemporal_load((const f32x4*)(x + i * 256 + lane * 4)); ss += v[i][0] * v[i][0] + v[i][1] * v[i][1] + v[i][2] * v[i][2] + v[i][3] * v[i][3]; }
#pragma unroll
    for (int m = 1; m < 64; m <<= 1) ss += __shfl_xor(ss, m);
    const float rstd = rsqrtf(ss * (1.f / 1024.f) + EPS);
    if (s != scur) { scur = s;
#pragma unroll
      for (int i = 0; i < 4; ++i) { const int c = i * 256 + lane * 4;
        const f32x4 g = *(const f32x4*)(p.norm_gain + c), sh = *(const f32x4*)(mod + s * 3072 + c), sc = *(const f32x4*)(mod + s * 3072 + 1024 + c);
        ca[i] = g * (1.f + sc); cb[i] = sh; } }
#pragma unroll
    for (int i = 0; i < 4; ++i) { const int c = i * 256 + lane * 4;
      const f32x4 h = v[i] * rstd * ca[i] + cb[i];
      u32x2 w; w.x = cvtpk(h[0], h[1]); w.y = cvtpk(h[2], h[3]); *(u32x2*)(hdst + (size_t)row * DM + c) = w; }
    if constexpr (WITH_OGN) {
      const bf16_t* of = (const bf16_t*)p.out + (size_t)row * DM; const bf16_t* ob = of + (size_t)NTOK * DM;
      bf16_t* ogn = (bf16_t*)(p.ws + OFF_OGN) + (size_t)row * DM;
#pragma unroll
      for (int i = 0; i < 2; ++i) { const int c = i * 512 + lane * 8;
        const u32x4 a = *(const u32x4*)(of + c), b = *(const u32x4*)(ob + c); float o[8]; float q = 0.f;
#pragma unroll
        for (int e = 0; e < 4; ++e) { o[2 * e] = bflo(a[e]) + bflo(b[e]); o[2 * e + 1] = bfhi(a[e]) + bfhi(b[e]); q += o[2 * e] * o[2 * e] + o[2 * e + 1] * o[2 * e + 1]; }
#pragma unroll
        for (int m = 1; m < 32; m <<= 1) q += __shfl_xor(q, m);
        const float r = rsqrtf(q * (1.f / 256.f) + EPS);
        const f32x4 g0 = gg0, g1 = gg1;
        u32x4 w; w.x = cvtpk(o[0] * r * g0[0], o[1] * r * g0[1]); w.y = cvtpk(o[2] * r * g0[2], o[3] * r * g0[3]);
        w.z = cvtpk(o[4] * r * g1[0], o[5] * r * g1[1]); w.w = cvtpk(o[6] * r * g1[2], o[7] * r * g1[3]);
        *(u32x4*)(ogn + c) = w; }
    }
  }
}

__device__ __forceinline__ int gsw(int row, int ch) { return row * 128 + ((ch ^ ((row >> 1) & 7)) << 4); }
struct GStage { bf16x8 ra[4], rb[2]; bool primed; };
template <bool SWAP>
__device__ __forceinline__ void gemm_tile(const bf16_t* __restrict__ A, int lda, const bf16_t* __restrict__ Bt, int ldb, int K, char* lds, f32x16 (&acc)[2][2],
                                          GStage& st, const bf16_t* __restrict__ nA, const bf16_t* __restrict__ nB, bool has_next) {
  int tid_ = threadIdx.x; asm volatile("" : "+v"(tid_));
  const int tid = tid_, lane = tid & 63, wid = tid >> 6, wm = wid >> 1, wn = wid & 1, c32 = lane & 31, hi = lane >> 5;
  const int srow = tid >> 3, sch = tid & 7;
  const bf16_t* ga = A + (size_t)srow * lda + sch * 8; const bf16_t* gb = Bt + (size_t)srow * ldb + sch * 8;
  const bf16_t* nga = nA + (size_t)srow * lda + sch * 8; const bf16_t* ngb = nB + (size_t)srow * ldb + sch * 8;
  bf16x8 (&ra)[4] = st.ra; bf16x8 (&rb)[2] = st.rb;
  const int nk = K >> 6;
#define G_LOAD(kt) do { _Pragma("unroll") for (int i = 0; i < 4; ++i) ra[i] = *(const bf16x8*)(ga + (size_t)(64 * i) * lda + (kt) * 64); \
    _Pragma("unroll") for (int i = 0; i < 2; ++i) rb[i] = *(const bf16x8*)(gb + (size_t)(64 * i) * ldb + (kt) * 64); } while (0)
#define G_WRITE(buf) do { char* sA_ = lds + (buf) * 49152; char* sB_ = sA_ + 32768; \
    _Pragma("unroll") for (int i = 0; i < 4; ++i) *(bf16x8*)(sA_ + gsw(srow + 64 * i, sch)) = ra[i]; \
    _Pragma("unroll") for (int i = 0; i < 2; ++i) *(bf16x8*)(sB_ + gsw(srow + 64 * i, sch)) = rb[i]; } while (0)
  if (!st.primed) G_LOAD(0);
  __syncthreads();
  G_WRITE(0);
  if (nk > 1) G_LOAD(1);
  __syncthreads();
  for (int kt = 0; kt < nk; ++kt) {
    const int cur = kt & 1;
    const char* sA = lds + cur * 49152; const char* sB = sA + 32768;
#define G_FRAG(FA, FB, ks) do { _Pragma("unroll") for (int i = 0; i < 2; ++i) { FA[i] = *(const bf16x8*)(sA + gsw(wm * 64 + i * 32 + c32, (ks) * 2 + hi)); FB[i] = *(const bf16x8*)(sB + gsw(wn * 64 + i * 32 + c32, (ks) * 2 + hi)); } } while (0)
#define G_MMA4(FA, FB) do { _Pragma("unroll") for (int mi = 0; mi < 2; ++mi) _Pragma("unroll") for (int ni = 0; ni < 2; ++ni) \
      acc[mi][ni] = SWAP ? __builtin_amdgcn_mfma_f32_32x32x16_bf16(FB[ni], FA[mi], acc[mi][ni], 0, 0, 0) : __builtin_amdgcn_mfma_f32_32x32x16_bf16(FA[mi], FB[ni], acc[mi][ni], 0, 0, 0); } while (0)
    { bf16x8 fa0[2], fb0[2], fa1[2], fb1[2];
      G_FRAG(fa0, fb0, 0); G_FRAG(fa1, fb1, 1); __builtin_amdgcn_sched_barrier(0);
      G_MMA4(fa0, fb0); __builtin_amdgcn_sched_barrier(0);
      if (kt + 1 < nk) { G_WRITE(cur ^ 1);
        if (kt + 2 < nk) G_LOAD(kt + 2);
        else if (has_next) {
#pragma unroll
          for (int i = 0; i < 4; ++i) ra[i] = *(const bf16x8*)(nga + (size_t)(64 * i) * lda);
#pragma unroll
          for (int i = 0; i < 2; ++i) rb[i] = *(const bf16x8*)(ngb + (size_t)(64 * i) * ldb); } }
      G_FRAG(fa0, fb0, 2); __builtin_amdgcn_sched_barrier(0);
      G_MMA4(fa1, fb1); __builtin_amdgcn_sched_barrier(0);
      G_FRAG(fa1, fb1, 3); __builtin_amdgcn_sched_barrier(0);
      G_MMA4(fa0, fb0); __builtin_amdgcn_sched_barrier(0);
      G_MMA4(fa1, fb1); }
#undef G_FRAG
#undef G_MMA4
    __syncthreads();
  }
  st.primed = has_next;
#undef G_LOAD
#undef G_WRITE
}
__device__ __forceinline__ void zero_acc(f32x16 (&acc)[2][2]) {
#pragma unroll
  for (int a = 0; a < 2; ++a)
#pragma unroll
    for (int b = 0; b < 2; ++b)
#pragma unroll
      for (int r = 0; r < 16; ++r) acc[a][b][r] = 0.f;
}
__device__ __forceinline__ void store_rows_bf16(const f32x16 (&acc)[2][2], bf16_t* dst, int ld, int tok0, int col0, int c32, int hi) {
#pragma unroll
  for (int mi = 0; mi < 2; ++mi)
#pragma unroll
    for (int ni = 0; ni < 2; ++ni)
#pragma unroll
      for (int g = 0; g < 4; g += 2) { const f32x16& v = acc[mi][ni];
        const unsigned x0 = cvtpk(v[4 * g], v[4 * g + 1]), x1 = cvtpk(v[4 * g + 2], v[4 * g + 3]), y0 = cvtpk(v[4 * g + 4], v[4 * g + 5]), y1 = cvtpk(v[4 * g + 6], v[4 * g + 7]);
        auto r0 = __builtin_amdgcn_permlane32_swap(x0, y0, false, false); auto r1 = __builtin_amdgcn_permlane32_swap(x1, y1, false, false);
        const u32x4 w = {r0[0], r1[0], r0[1], r1[1]};
        *(u32x4*)(dst + (size_t)(tok0 + mi * 32 + c32) * ld + col0 + ni * 32 + 8 * (g + hi)) = w; }
}

__device__ __forceinline__ bool patch_tile(int r, int NT, int& mt, int& nt) {
  const int nb = gridDim.x, per = nb >> 3, b = blockIdx.x;
  const int t = (nb & 7) ? r * nb + b : r * nb + (b & 7) * per + (b >> 3);
  if (t >= (NTOK / 256) * NT) return false;
  const int gsz = 4 * NT, grp = t / gsz, rem = t - grp * gsz; nt = rem >> 2; mt = grp * 4 + (rem & 3); return true;
}
__device__ NOINL void phase1(const Params& p) {
  char* lds = g_lds;
  int tid_ = threadIdx.x; asm volatile("" : "+v"(tid_));
  const int tid = tid_, lane = tid & 63, wid = tid >> 6, wm = wid >> 1, wn = wid & 1, c32 = lane & 31, hi = lane >> 5;
  const bf16_t* H = (const bf16_t*)((const char*)p.out + SZ_FULL);
  const bf16_t* W = (const bf16_t*)(p.ws + OFF_WP1);
  const f32x2* ropeHi = (const f32x2*)(p.ws + OFF_ROPE); const f32x2* ropeLo = ropeHi + 4096;
  constexpr int NT = NP1 / 128;
  GStage st; st.primed = false;
  int mt, nt; bool have = patch_tile(0, NT, mt, nt);
  for (int rr = 0; have; ++rr) {
    int mt2 = 0, nt2 = 0; const bool have2 = patch_tile(rr + 1, NT, mt2, nt2);
    const bf16_t* nA = H + (size_t)(mt2 * 256) * DM; const bf16_t* nB = W + (size_t)(nt2 * 128) * DM;
    const int m0 = mt * 256, n0 = nt * 128;
    f32x16 acc[2][2]; zero_acc(acc);
    const int rw = m0 + wm * 64, cw = n0 + wn * 64;
    if (nt >= 8 && nt < 16) {
      gemm_tile<false>(H + (size_t)m0 * DM, DM, W + (size_t)n0 * DM, DM, DM, lds, acc, st, nA, nB, false);
      bf16_t* dst = (bf16_t*)(p.ws + OFF_GV); const int cb = cw - 1024;
#pragma unroll
      for (int mi = 0; mi < 2; ++mi)
#pragma unroll
        for (int ni = 0; ni < 2; ++ni)
#pragma unroll
          for (int q = 0; q < 4; ++q) { u32x2 w; w.x = cvtpk(acc[mi][ni][4 * q], acc[mi][ni][4 * q + 1]); w.y = cvtpk(acc[mi][ni][4 * q + 2], acc[mi][ni][4 * q + 3]);
            *(u32x2*)(dst + (size_t)(cb + ni * 32 + c32) * NTOK + rw + mi * 32 + 8 * q + 4 * hi) = w; }
      mt = mt2; nt = nt2; have = have2;
      continue;
    }
    gemm_tile<true>(H + (size_t)m0 * DM, DM, W + (size_t)n0 * DM, DM, DM, lds, acc, st, nA, nB, false);
    if (nt < 8) {
      if (nt < 4) {
#pragma unroll
        for (int mi = 0; mi < 2; ++mi)
#pragma unroll
          for (int ni = 0; ni < 2; ++ni) acc[mi][ni] = acc[mi][ni] * 0.08838834764831845f;
        store_rows_bf16(acc, (bf16_t*)(p.ws + OFF_GQ), 512, rw, cw, c32, hi);
      } else store_rows_bf16(acc, (bf16_t*)(p.ws + OFF_GK), 512, rw, cw - 512, c32, hi);
    } else if (nt < 32) {
      const int pos0 = m0 < LP ? m0 : (m0 & (LS - 1));
      const float qsc = nt < 24 ? 0.18033688011112042f : 1.f;
      const f32x2* thp = ropeHi + ((pos0 >> 7) + (wm >> 1)) * 32 + 4 * hi;
#pragma unroll
      for (int mi = 0; mi < 2; ++mi) { const f32x2* tlp = ropeLo + ((wm * 64 + mi * 32 + c32) & 127) * 32 + 4 * hi;
#pragma unroll
        for (int g = 0; g < 4; ++g) { const f32x4 ta = *(const f32x4*)(thp + 8 * g), tb = *(const f32x4*)(thp + 8 * g + 2), la = *(const f32x4*)(tlp + 8 * g), lb = *(const f32x4*)(tlp + 8 * g + 2);
          const float thx[4] = {ta[0], ta[2], tb[0], tb[2]}, thy[4] = {ta[1], ta[3], tb[1], tb[3]}, tlx[4] = {la[0], la[2], lb[0], lb[2]}, tly[4] = {la[1], la[3], lb[1], lb[3]};
#pragma unroll
          for (int e = 0; e < 4; ++e) { const int r = 4 * g + e; const float c = thx[e] * tlx[e] - thy[e] * tly[e], s = thy[e] * tlx[e] + thx[e] * tly[e];
            const float x1 = acc[mi][0][r] * qsc, x2 = acc[mi][1][r] * qsc; acc[mi][0][r] = x1 * c - x2 * s; acc[mi][1][r] = x1 * s + x2 * c; } } }
      { const int cb = cw - (nt < 24 ? 2048 : 3072);
        store_rows_bf16(acc, (bf16_t*)(p.ws + (nt < 24 ? OFF_DQ : OFF_DK)) + (size_t)(cb >> 7) * NTOK * 128, 128, rw, cb & 127, c32, hi); }
    } else if (nt < 40) {
      { const int cb = cw - 4096; store_rows_bf16(acc, (bf16_t*)(p.ws + OFF_DV) + (size_t)(cb >> 7) * NTOK * 128, 128, rw, cb & 127, c32, hi); }
    } else if (wn == 0) {
      float* dst = (float*)(p.ws + OFF_LOW);
#pragma unroll
      for (int mi = 0; mi < 2; ++mi)
#pragma unroll
        for (int g = 0; g < 4; ++g) *(f32x4*)(dst + (size_t)(rw + mi * 32 + c32) * 32 + 8 * g + 4 * hi) = (f32x4){acc[mi][0][4 * g], acc[mi][0][4 * g + 1], acc[mi][0][4 * g + 2], acc[mi][0][4 * g + 3]};
    }
    mt = mt2; nt = nt2; have = have2;
  }
}

constexpr int GQT = 0, GKT = 17408, GKH = 34816, GVT = 53248, GSC = 90112, GLWA = 99328, GDEC = 104448, GLA_LDS = 104960;
constexpr int QROW = 272, HROW = 144, LROW = 80;
__device__ __forceinline__ unsigned rot16(unsigned x) { return (x >> 16) | (x << 16); }

__device__ __forceinline__ void gla_item(const Params& p, int s, int hh, int dir, char* lds) {
  int tid_ = threadIdx.x; asm volatile("" : "+v"(tid_));
  const int tid = tid_, lane = tid & 63, wid = __builtin_amdgcn_readfirstlane(tid >> 6), n16 = lane & 15, g4 = lane >> 4;
  const int base = seq_base(s), L = seq_len(s), nchunk = L >> 6;
  const bf16_t* GQ = (const bf16_t*)(p.ws + OFF_GQ) + hh * 128; const bf16_t* GK = (const bf16_t*)(p.ws + OFF_GK) + hh * 128;
  const bf16_t* GVg = (const bf16_t*)(p.ws + OFF_GV) + (size_t)(hh * 256) * NTOK; const float* LOW = (const float*)(p.ws + OFF_LOW) + dir * 16;
  bf16_t* OUT = (bf16_t*)p.out + (size_t)dir * NTOK * DM + hh * 256 + wid * 32;
  bf16x8 B1, B2; float ba;
  { const int d = hh * 128 + wid * 16 + n16; float wh[8], wl[8];
#pragma unroll
    for (int e = 0; e < 8; ++e) { const float w = p.w_alpha[(size_t)(dir * 16 + (g4 & 1) * 8 + e) * 512 + d]; const float h = bf2f(f2bf(w)); wh[e] = h; wl[e] = (g4 < 2) ? (w - h) : 0.f; }
    u32x4 a = {cvtpk(wh[0], wh[1]), cvtpk(wh[2], wh[3]), cvtpk(wh[4], wh[5]), cvtpk(wh[6], wh[7])}; B1 = *(bf16x8*)&a;
    u32x4 c = {cvtpk(wl[0], wl[1]), cvtpk(wl[2], wl[3]), cvtpk(wl[4], wl[5]), cvtpk(wl[6], wl[7])}; B2 = *(bf16x8*)&c;
    ba = p.b_alpha[dir * 512 + d]; }
  f32x4 S[2][8];
#pragma unroll
  for (int nb = 0; nb < 2; ++nb)
#pragma unroll
    for (int b = 0; b < 8; ++b) S[nb][b] = (f32x4){0.f, 0.f, 0.f, 0.f};
  bf16x8 rq[2], rk[2]; u32x4 rv[4]; f32x4 rl = {0.f, 0.f, 0.f, 0.f};
#define GLA_TOK0(c) (dir == 0 ? (c) * 64 : L - 64 * ((c) + 1))
#define GLA_LOAD(c) do { const size_t r0 = (size_t)(base + GLA_TOK0(c)); \
    _Pragma("unroll") for (int i = 0; i < 2; ++i) { const int id = tid + NTHR * i, j = id >> 4, ch = id & 15; rq[i] = *(const bf16x8*)(GQ + (r0 + j) * 512 + ch * 8); rk[i] = *(const bf16x8*)(GK + (r0 + j) * 512 + ch * 8); } \
    _Pragma("unroll") for (int i = 0; i < 4; ++i) { const int id = tid + NTHR * i, e = id >> 3, jq = id & 7; rv[i] = *(const u32x4*)(GVg + (size_t)e * NTOK + r0 + jq * 8); } \
    if (tid < 256) { const int j = tid >> 2, pt = tid & 3; rl = *(const f32x4*)(LOW + (r0 + j) * 32 + pt * 4); } } while (0)
  GLA_LOAD(0);
  for (int c = 0; c < nchunk; ++c) {
    __syncthreads();
#pragma unroll
    for (int i = 0; i < 2; ++i) { const int id = tid + NTHR * i, jm = id >> 4, ch = id & 15, j = dir ? 63 - jm : jm;
      *(bf16x8*)(lds + GQT + j * QROW + ch * 16) = rq[i]; *(bf16x8*)(lds + GKT + j * QROW + ch * 16) = rk[i]; }
#pragma unroll
    for (int i = 0; i < 4; ++i) { const int id = tid + NTHR * i, e = id >> 3, jq = id & 7; u32x4 w = rv[i];
      if (dir) { w = (u32x4){rot16(rv[i].w), rot16(rv[i].z), rot16(rv[i].y), rot16(rv[i].x)}; }
      *(u32x4*)(lds + GVT + e * HROW + (dir ? 7 - jq : jq) * 16) = w; }
    if (tid < 256) { const int jm = tid >> 2, pt = tid & 3, j = dir ? 63 - jm : jm;
      const float h0 = bf2f(f2bf(rl[0])), h1 = bf2f(f2bf(rl[1])), h2 = bf2f(f2bf(rl[2])), h3 = bf2f(f2bf(rl[3]));
      u32x2 wh = {cvtpk(h0, h1), cvtpk(h2, h3)}, wl = {cvtpk(rl[0] - h0, rl[1] - h1), cvtpk(rl[2] - h2, rl[3] - h3)};
      *(u32x2*)(lds + GLWA + j * LROW + pt * 8) = wh; *(u32x2*)(lds + GLWA + j * LROW + 32 + pt * 8) = wl; }
    __syncthreads();
    if (c + 1 < nchunk) GLA_LOAD(c + 1);
    {
      float bb[16]; float carry = 0.f;
#pragma unroll
      for (int jb = 0; jb < 4; ++jb) {
        const bf16x8 la = *(const bf16x8*)(lds + GLWA + (jb * 16 + n16) * LROW + g4 * 16);
        f32x4 x = {ba, ba, ba, ba};
        x = __builtin_amdgcn_mfma_f32_16x16x32_bf16(la, B1, x, 0, 0, 0); x = __builtin_amdgcn_mfma_f32_16x16x32_bf16(la, B2, x, 0, 0, 0);
        float sc4[4]; float run = 0.f;
#pragma unroll
        for (int r = 0; r < 4; ++r) { const float lg = x[r]; run += (fminf(lg, 0.f) - __logf(1.f + __expf(-fabsf(lg)))) * 0.0625f; sc4[r] = run; }
        float inc = run; float u = __shfl_up(inc, 16); if (g4 >= 1) inc += u; u = __shfl_up(inc, 32); if (g4 >= 2) inc += u;
        const float ex = carry + (inc - run);
#pragma unroll
        for (int r = 0; r < 4; ++r) bb[jb * 4 + r] = ex + sc4[r];
        carry += __shfl(inc, 48 + n16);
      }
      const float eblast = __expf(carry); const int d = wid * 16 + n16;
      if (g4 == 0) ((float*)(lds + GDEC))[d] = eblast;
#pragma unroll
      for (int jb = 0; jb < 4; ++jb) { float kh[4];
#pragma unroll
        for (int r = 0; r < 4; ++r) { const int j = jb * 16 + g4 * 4 + r; const float b = bb[jb * 4 + r], e1 = __expf(b), e2 = __expf(-b);
          bf16_t* qp = (bf16_t*)(lds + GQT + j * QROW + d * 2); bf16_t* kp = (bf16_t*)(lds + GKT + j * QROW + d * 2);
          const float qv = bf2f(*qp), kv = bf2f(*kp); *qp = f2bf(qv * e1); const float kt = kv * e2; *kp = f2bf(kt); kh[r] = kt * eblast; }
        u32x2 w = {cvtpk(kh[0], kh[1]), cvtpk(kh[2], kh[3])};
        *(u32x2*)(lds + GKH + d * HROW + (jb * 16 + g4 * 4) * 2) = w; }
    }
    __syncthreads();
    {
      const int ib = wid >> 1;
      bf16x8 aq[4];
#pragma unroll
      for (int ks = 0; ks < 4; ++ks) aq[ks] = *(const bf16x8*)(lds + GQT + (ib * 16 + n16) * QROW + (ks * 32 + g4 * 8) * 2);
#pragma unroll
      for (int jj = 0; jj < 2; ++jj) { const int jb = (wid & 1) * 2 + jj; f32x4 a = {0.f, 0.f, 0.f, 0.f};
        if (jb <= ib) {
#pragma unroll
          for (int ks = 0; ks < 4; ++ks) { const bf16x8 bk = *(const bf16x8*)(lds + GKT + (jb * 16 + n16) * QROW + (ks * 32 + g4 * 8) * 2);
            a = __builtin_amdgcn_mfma_f32_16x16x32_bf16(aq[ks], bk, a, 0, 0, 0); } }
#pragma unroll
        for (int r = 0; r < 4; ++r) { float v = a[r]; if (jb == ib && n16 > g4 * 4 + r) v = 0.f;
          *(bf16_t*)(lds + GSC + (ib * 16 + g4 * 4 + r) * HROW + (jb * 16 + n16) * 2) = f2bf(v); } }
    }
    __syncthreads();
    {
      bf16x8 sb[2][4];
#pragma unroll
      for (int nb = 0; nb < 2; ++nb)
#pragma unroll
        for (int ks = 0; ks < 4; ++ks) { u32x4 w; w.x = cvtpk(S[nb][2 * ks][0], S[nb][2 * ks][1]); w.y = cvtpk(S[nb][2 * ks][2], S[nb][2 * ks][3]);
          w.z = cvtpk(S[nb][2 * ks + 1][0], S[nb][2 * ks + 1][1]); w.w = cvtpk(S[nb][2 * ks + 1][2], S[nb][2 * ks + 1][3]); sb[nb][ks] = *(bf16x8*)&w; }
      bf16x8 vf[2][2];
#pragma unroll
      for (int nb = 0; nb < 2; ++nb)
#pragma unroll
        for (int k2 = 0; k2 < 2; ++k2) vf[nb][k2] = *(const bf16x8*)(lds + GVT + (wid * 32 + nb * 16 + n16) * HROW + (k2 * 32 + g4 * 8) * 2);
      const size_t r0 = (size_t)(base + GLA_TOK0(c));
#pragma unroll
      for (int ib = 0; ib < 4; ++ib) { f32x4 o[2] = {{0.f, 0.f, 0.f, 0.f}, {0.f, 0.f, 0.f, 0.f}};
#pragma unroll
        for (int ks = 0; ks < 4; ++ks) { const char* qp = lds + GQT + (ib * 16 + n16) * QROW + (ks * 32 + g4 * 4) * 2;
          const u32x2 lo = *(const u32x2*)qp, hi2 = *(const u32x2*)(qp + 32); u32x4 w = {lo.x, lo.y, hi2.x, hi2.y}; const bf16x8 a = *(bf16x8*)&w;
          o[0] = __builtin_amdgcn_mfma_f32_16x16x32_bf16(sb[0][ks], a, o[0], 0, 0, 0); o[1] = __builtin_amdgcn_mfma_f32_16x16x32_bf16(sb[1][ks], a, o[1], 0, 0, 0); }
#pragma unroll
        for (int k2 = 0; k2 < 2; ++k2) { const bf16x8 a = *(const bf16x8*)(lds + GSC + (ib * 16 + n16) * HROW + (k2 * 32 + g4 * 8) * 2);
          o[0] = __builtin_amdgcn_mfma_f32_16x16x32_bf16(vf[0][k2], a, o[0], 0, 0, 0); o[1] = __builtin_amdgcn_mfma_f32_16x16x32_bf16(vf[1][k2], a, o[1], 0, 0, 0); }
        { const int j = ib * 16 + n16; const size_t row = r0 + (dir ? 63 - j : j);
          u32x2 w0 = {cvtpk(o[0][0], o[0][1]), cvtpk(o[0][2], o[0][3])}, w1 = {cvtpk(o[1][0], o[1][1]), cvtpk(o[1][2], o[1][3])};
          *(u32x2*)(OUT + row * DM + g4 * 4) = w0; *(u32x2*)(OUT + row * DM + 16 + g4 * 4) = w1; } }
      const float* dec = (const float*)(lds + GDEC);
#pragma unroll
      for (int b = 0; b < 8; ++b) { const f32x4 dc = *(const f32x4*)(dec + b * 16 + g4 * 4);
        S[0][b] = S[0][b] * dc; S[1][b] = S[1][b] * dc;
#pragma unroll
        for (int k2 = 0; k2 < 2; ++k2) { const bf16x8 a = *(const bf16x8*)(lds + GKH + (b * 16 + n16) * HROW + (k2 * 32 + g4 * 8) * 2);
          S[0][b] = __builtin_amdgcn_mfma_f32_16x16x32_bf16(a, vf[0][k2], S[0][b], 0, 0, 0); S[1][b] = __builtin_amdgcn_mfma_f32_16x16x32_bf16(a, vf[1][k2], S[1][b], 0, 0, 0); } }
    }
  }
  __syncthreads();
#undef GLA_LOAD
#undef GLA_TOK0
}

constexpr int SHM_V = 16384, SHM_K = 16384, ATT_LDS = 2 * SHM_V + 2 * SHM_K + 8 * 512;
#define KSWZ(row, colB) ((row) * 256 + ((colB) ^ (((row) & 7) << 4)))
#define SBAR() __builtin_amdgcn_sched_barrier(0)
constexpr float ATT_SCALE = 0.125f, ATT_THR = 8.f;
constexpr float ATT_THR2 = ATT_THR * 1.4426950408889634f;
__device__ __forceinline__ void partialSM(f32x16& p0, f32x16& p1, float& m_reg, float& alpha, f32x16& negv, bool first) {
  float tmax = p0[0];
#pragma unroll
  for (int r = 1; r < 16; ++r) tmax = fmaxf(tmax, p0[r]);
#pragma unroll
  for (int r = 0; r < 16; ++r) tmax = fmaxf(tmax, p1[r]);
  { auto rr = __builtin_amdgcn_permlane32_swap(__float_as_uint(tmax), __float_as_uint(tmax), false, false); tmax = fmaxf(__uint_as_float(rr[0]), __uint_as_float(rr[1])); }
  alpha = 1.f;
  if (__builtin_expect(first || !__all(tmax <= ATT_THR2), 0)) {
    const float d = first ? tmax : fmaxf(tmax, 0.f);
    if (!first) alpha = __builtin_amdgcn_exp2f(-d);
    m_reg += d;
#pragma unroll
    for (int r = 0; r < 16; ++r) { p0[r] -= d; p1[r] -= d; negv[r] = -m_reg; }
  }
#pragma unroll
  for (int r = 0; r < 16; ++r) { p0[r] = __builtin_amdgcn_exp2f(p0[r]); p1[r] = __builtin_amdgcn_exp2f(p1[r]); }
}
__device__ __forceinline__ void finishSM(const f32x16& p0, const f32x16& p1, float alpha, float& l_reg, bf16x8& pa0, bf16x8& pa1, bf16x8& pa2, bf16x8& pa3) {
  float ps = 0.f;
#pragma unroll
  for (int r = 0; r < 16; ++r) ps += p0[r] + p1[r];
  { auto rr = __builtin_amdgcn_permlane32_swap(__float_as_uint(ps), __float_as_uint(ps), false, false); ps = __uint_as_float(rr[0]) + __uint_as_float(rr[1]); }
  l_reg = l_reg * alpha + ps;
#define PK4(P, BASE, OUTV) do { unsigned a0 = cvtpk(P[BASE + 0], P[BASE + 1]), a1 = cvtpk(P[BASE + 2], P[BASE + 3]);   \
    unsigned b0 = cvtpk(P[BASE + 4], P[BASE + 5]), b1 = cvtpk(P[BASE + 6], P[BASE + 7]);                              \
    auto r0 = __builtin_amdgcn_permlane32_swap(a0, b0, false, false); auto r1 = __builtin_amdgcn_permlane32_swap(a1, b1, false, false); \
    u32x4 w = {r0[0], r1[0], r0[1], r1[1]}; OUTV = *reinterpret_cast<bf16x8*>(&w); } while (0)
  PK4(p0, 0, pa0); PK4(p0, 8, pa1); PK4(p1, 0, pa2); PK4(p1, 8, pa3);
#undef PK4
}
__device__ __forceinline__ void qkt(f32x16& p0, f32x16& p1, const char* Ks, const bf16x8* qr, int r32, int hi, int z, const f32x16& negv) {
  p0 = negv; p1 = negv;
#pragma unroll
  for (int d0 = 0; d0 < 4; ++d0) { const int cb = ((z * 4 + d0) * 16 + hi * 8) * 2;
    const bf16x8 b0 = *reinterpret_cast<const bf16x8*>(Ks + KSWZ(r32, cb)); const bf16x8 b1 = *reinterpret_cast<const bf16x8*>(Ks + KSWZ(32 + r32, cb));
    p0 = __builtin_amdgcn_mfma_f32_32x32x16_bf16(b0, qr[d0], p0, 0, 0, 0); p1 = __builtin_amdgcn_mfma_f32_32x32x16_bf16(b1, qr[d0], p1, 0, 0, 0); }
}
__device__ __forceinline__ int v_st(int k, int c) { const int kk = (k & ~0xC) | ((k & 4) << 1) | ((k & 8) >> 1); return ((kk >> 3) * 4 + (c >> 5)) * 512 + ((kk & 7) * 32 + (c & 31)) * 2; }
__device__ __forceinline__ int v_rd_base(int lane) { return ((lane & 3) << 3) | (((lane >> 2) & 3) << 6) | (((lane >> 4) & 1) << 5) | (((lane >> 5) & 1) << 8); }
constexpr int v_rd_off(int d0, int ks, int half) { return d0 * 512 + ks * 4096 + half * 2048; }
template <int OFF> __device__ __forceinline__ s16x4 tr_read(int vb) { s16x4 r; asm volatile("ds_read_b64_tr_b16 %0, %1 offset:%2" : "=&v"(r) : "v"(vb), "i"(OFF) : "memory"); return r; }
struct VFrag { s16x4 l0, h0, l1, h1, l2, h2, l3, h3; };
template <int D0> __device__ __forceinline__ void pv_read(VFrag& f, int vb) {
  f.l0 = tr_read<v_rd_off(D0, 0, 0)>(vb); f.h0 = tr_read<v_rd_off(D0, 0, 1)>(vb); f.l1 = tr_read<v_rd_off(D0, 1, 0)>(vb); f.h1 = tr_read<v_rd_off(D0, 1, 1)>(vb);
  f.l2 = tr_read<v_rd_off(D0, 2, 0)>(vb); f.h2 = tr_read<v_rd_off(D0, 2, 1)>(vb); f.l3 = tr_read<v_rd_off(D0, 3, 0)>(vb); f.h3 = tr_read<v_rd_off(D0, 3, 1)>(vb);
}
__device__ __forceinline__ void pv_mma(f32x16& od, const VFrag& f, bf16x8 pa0, bf16x8 pa1, bf16x8 pa2, bf16x8 pa3) {
#define PKV(L, H) (bf16x8){L[0], L[1], L[2], L[3], H[0], H[1], H[2], H[3]}
  od = __builtin_amdgcn_mfma_f32_32x32x16_bf16(pa0, PKV(f.l0, f.h0), od, 0, 0, 0);
  od = __builtin_amdgcn_mfma_f32_32x32x16_bf16(pa1, PKV(f.l1, f.h1), od, 0, 0, 0);
  od = __builtin_amdgcn_mfma_f32_32x32x16_bf16(pa2, PKV(f.l2, f.h2), od, 0, 0, 0);
  od = __builtin_amdgcn_mfma_f32_32x32x16_bf16(pa3, PKV(f.l3, f.h3), od, 0, 0, 0);
#undef PKV
}
__device__ __forceinline__ void pv_d0(f32x16* o, int vb, bf16x8 pa0, bf16x8 pa1, bf16x8 pa2, bf16x8 pa3) {
  VFrag fa, fb;
  pv_read<0>(fa, vb);
  pv_read<1>(fb, vb); asm volatile("s_waitcnt lgkmcnt(8)" ::: "memory"); SBAR();
  pv_mma(o[0], fa, pa0, pa1, pa2, pa3); SBAR();
  pv_read<2>(fa, vb); asm volatile("s_waitcnt lgkmcnt(8)" ::: "memory"); SBAR();
  pv_mma(o[1], fb, pa0, pa1, pa2, pa3); SBAR();
  pv_read<3>(fb, vb); asm volatile("s_waitcnt lgkmcnt(8)" ::: "memory"); SBAR();
  pv_mma(o[2], fa, pa0, pa1, pa2, pa3); SBAR();
  asm volatile("s_waitcnt lgkmcnt(0)" ::: "memory"); SBAR();
  pv_mma(o[3], fb, pa0, pa1, pa2, pa3);
}

__device__ __forceinline__ void attn_item(const bf16_t* Qb, const bf16_t* Kh, const bf16_t* Vh, bf16_t* Ob, int seq, char* lds, float lam, const float* gain) {
  int tid_ = threadIdx.x; asm volatile("" : "+v"(tid_));
  const int tid = tid_, wid = __builtin_amdgcn_readfirstlane(tid >> 6), lane = tid & 63, r32 = lane & 31, hi = lane >> 5, qg = wid >> 1, z = wid & 1;
  char* V_lds = lds; char* K_lds = lds + 3 * SHM_V;
  float* wsf = (float*)(lds + 3 * SHM_V + 2 * SHM_K) + wid * 128; float* al_l = wsf; float* li = wsf + 32;
  float m = 0.f, l = 0.f; f32x16 o[4]; bf16x8 qr[4]; f32x16 negv;
#pragma unroll
  for (int r = 0; r < 16; ++r) negv[r] = 0.f;
#pragma unroll
  for (int d = 0; d < 4; ++d)
#pragma unroll
    for (int r = 0; r < 16; ++r) o[d][r] = 0.f;
  const bf16_t* Qw = Qb + (size_t)(qg * 32 + r32) * 128 + z * 64 + hi * 8;
#pragma unroll
  for (int d0 = 0; d0 < 4; ++d0) qr[d0] = *(const bf16x8*)(Qw + d0 * 16);
  const int sr = tid >> 4, sc = (tid & 15) * 8;
  const int vb0 = (int)(uintptr_t)V_lds + v_rd_base(lane);
  bf16x8 sv[2], sk[2];
#define LOADKV(SK, SV, k0) do { _Pragma("unroll") for (int i = 0; i < 2; ++i) { SK[i] = *(const bf16x8*)(Kh + (size_t)((k0) + sr + 32 * i) * 128 + sc); SV[i] = *(const bf16x8*)(Vh + (size_t)((k0) + sr + 32 * i) * 128 + sc); } } while (0)
#define WRITEKV(SK, SV, kb, vb) do { _Pragma("unroll") for (int i = 0; i < 2; ++i) { *(bf16x8*)(K_lds + (kb) * SHM_K + KSWZ(sr + 32 * i, sc * 2)) = SK[i]; *(bf16x8*)(V_lds + (vb) * SHM_V + v_st(sr + 32 * i, sc)) = SV[i]; } } while (0)
  const int NT = seq >> 6;
  const bool late = wid >= 4;
  bf16x8 pa0, pa1, pa2, pa3;
  bf16x8 skB[2], svB[2];
#define ATT_INTERVAL(j, kb, vcur, vprev) do { \
    if (late && (j) > 0) { pv_d0(o, vb0 + (vprev) * SHM_V, pa0, pa1, pa2, pa3); SBAR(); } \
    { f32x16 p0, p1; float al; \
      qkt(p0, p1, K_lds + (kb) * SHM_K, qr, r32, hi, z, negv); \
      partialSM(p0, p1, m, al, negv, (j) == 0); \
      SBAR(); \
      if (__any(al < 1.f)) { if (hi == 0) al_l[r32] = al; asm volatile("s_waitcnt lgkmcnt(0)" ::: "memory"); \
        _Pragma("unroll") for (int r = 0; r < 16; ++r) { const float f = al_l[crow(r, hi)]; _Pragma("unroll") for (int d = 0; d < 4; ++d) o[d][r] *= f; } } \
      finishSM(p0, p1, al, l, pa0, pa1, pa2, pa3); SBAR(); } \
    if (!late) { pv_d0(o, vb0 + (vcur) * SHM_V, pa0, pa1, pa2, pa3); SBAR(); } } while (0)
  __syncthreads();
  LOADKV(sk, sv, 0); WRITEKV(sk, sv, 0, 0);
  LOADKV(sk, sv, 64); LOADKV(skB, svB, 128);
  __syncthreads();
  int vcur = 0;
  for (int j = 0; j < NT; j += 2) {
    { const int vnext = vcur == 2 ? 0 : vcur + 1, vprev = vcur == 0 ? 2 : vcur - 1;
      SBAR();
      ATT_INTERVAL(j, 0, vcur, vprev);
      WRITEKV(sk, sv, 1, vnext);
      if (j + 3 < NT) LOADKV(sk, sv, (j + 3) * 64);
      __syncthreads();
      vcur = vnext; }
    { const int vnext = vcur == 2 ? 0 : vcur + 1, vprev = vcur == 0 ? 2 : vcur - 1;
      SBAR();
      ATT_INTERVAL(j + 1, 1, vcur, vprev);
      if (j + 2 < NT) { WRITEKV(skB, svB, 0, vnext); if (j + 4 < NT) LOADKV(skB, svB, (j + 4) * 64); }
      __syncthreads();
      vcur = vnext; }
  }
#undef ATT_INTERVAL
  if (late) { const int vlast = vcur == 0 ? 2 : vcur - 1; pv_d0(o, vb0 + vlast * SHM_V, pa0, pa1, pa2, pa3); }
  __syncthreads();
  if (hi == 0) li[r32] = l;
  asm volatile("s_waitcnt lgkmcnt(0)" ::: "memory");
  float* xch = (float*)lds + qg * 4096;
  if (z == 1) {
#pragma unroll
    for (int r = 0; r < 16; ++r) { const int rr = crow(r, hi); const float f = lam / li[rr];
#pragma unroll
      for (int d = 0; d < 4; ++d) xch[rr * 128 + d * 32 + r32] = o[d][r] * f; }
  }
  __syncthreads();
  if (z == 0) {
    float g4v[4];
#pragma unroll
    for (int d = 0; d < 4; ++d) g4v[d] = gain[d * 32 + r32] * 0.8f;
#pragma unroll
    for (int r = 0; r < 16; ++r) { const int rr = crow(r, hi); const float i0 = 1.f / li[rr]; float q = 0.f;
#pragma unroll
      for (int d = 0; d < 4; ++d) { const float v = o[d][r] * i0 - xch[rr * 128 + d * 32 + r32]; o[d][r] = v; q += v * v; }
#pragma unroll
      for (int mm = 1; mm < 32; mm <<= 1) q += __shfl_xor(q, mm);
      const float rs = rsqrtf(q * (1.f / 128.f) + EPS);
      bf16_t* orow = Ob + (size_t)(qg * 32 + rr) * 128 + r32;
#pragma unroll
      for (int d = 0; d < 4; ++d) orow[d * 32] = f2bf(o[d][r] * rs * g4v[d]); }
  }
#undef LOADKV
#undef WRITEKV
}

constexpr int XQ_GP = 1, XQ_AP = 128, XQ_GS = 8, XQ_AS = 256, XQ_ITEMS = XQ_GP + XQ_AP + XQ_GS + XQ_AS;
__device__ __forceinline__ unsigned xcc_id() { return (unsigned)__builtin_amdgcn_s_getreg((3 << 11) | 20) & 0xFu; }
__device__ NOINL void phase2(const Params& p) {
  char* lds = g_lds;
  unsigned* qctr = (unsigned*)(p.ws + OFF_MISC) + 64;
  const float lam = ((const float*)(p.ws + OFF_MISC))[0];
  int* slot = (int*)(lds + LDS_BYTES - 64);
  const int x0 = (int)(xcc_id() & 7u);
  for (int xi = 0; xi < 8; ++xi) {
    const int x = (x0 + xi) & 7;
    for (;;) {
      __syncthreads();
      if (threadIdx.x == 0) *slot = (int)atomicAdd(qctr + x * 32, 1u);
      __syncthreads();
      int it = *slot;
      if (it >= XQ_ITEMS) break;
      bool is_gla; int s, a1, a2;
      if (it < XQ_GP) { const int g = x * XQ_GP + it; is_gla = true; s = 0; a1 = g >> 1; a2 = g & 1; }
      else if ((it -= XQ_GP) < XQ_AP) { is_gla = false; s = 0; a1 = x; a2 = it; }
      else if ((it -= XQ_AP) < XQ_GS) { const int g = x * XQ_GS + it; is_gla = true; s = 1 + (g >> 3); const int r = g & 7; a1 = r >> 1; a2 = r & 1; }
      else { it -= XQ_GS; is_gla = false; s = 1 + (it >> 5); a1 = x; a2 = it & 31; }
      if (is_gla) gla_item(p, s, a1, a2, lds);
      else { const size_t sb = ((size_t)a1 * NTOK + seq_base(s)) * 128, qo = sb + (size_t)(a2 * 128) * 128;
        attn_item((const bf16_t*)(p.ws + OFF_DQ) + qo, (const bf16_t*)(p.ws + OFF_DK) + sb, (const bf16_t*)(p.ws + OFF_DV) + sb, (bf16_t*)(p.ws + OFF_DQ) + qo, seq_len(s), lds, lam, p.diff_norm_gain); }
    }
  }
}

__device__ NOINL void phase3a(const Params& p) {
  char* lds = g_lds;
  int tid_ = threadIdx.x; asm volatile("" : "+v"(tid_));
  const int tid = tid_, lane = tid & 63, wid = tid >> 6, wm = wid >> 1, wn = wid & 1, c32 = lane & 31, hi = lane >> 5;
  const bf16_t* H = (const bf16_t*)(p.ws + OFF_H3); const bf16_t* W = (const bf16_t*)(p.ws + OFF_WP3);
  constexpr int NT = 16;
  GStage st; st.primed = false;
  int mt, nt; bool have = patch_tile(0, NT, mt, nt);
  for (int rr = 0; have; ++rr) {
    int mt2 = 0, nt2 = 0; const bool have2 = patch_tile(rr + 1, NT, mt2, nt2);
    const int m0 = mt * 256, n0 = nt * 128;
    f32x16 acc[2][2]; zero_acc(acc);
    gemm_tile<true>(H + (size_t)m0 * DM, DM, W + (size_t)n0 * DM, DM, DM, lds, acc, st, H + (size_t)(mt2 * 256) * DM, W + (size_t)(nt2 * 128) * DM, have2);
    const int rw = m0 + wm * 64, cw = (n0 & 1023) + wn * 64, seg = nt >> 3;
    const bf16_t* src = (const bf16_t*)(p.ws + (seg == 0 ? OFF_OGN : OFF_DQ));
    bf16_t* dst = seg == 0 ? (bf16_t*)(p.ws + OFF_A2) : seg == 1 ? (bf16_t*)(p.ws + OFF_A3) : seg == 2 ? (bf16_t*)p.out : (bf16_t*)p.out + (size_t)NTOK * DM;
#pragma unroll
    for (int mi = 0; mi < 2; ++mi)
#pragma unroll
      for (int ni = 0; ni < 2; ++ni)
#pragma unroll
        for (int g = 0; g < 4; ++g) {
          if (seg < 2) { const int tok = rw + mi * 32 + c32, col = cw + ni * 32 + 8 * g + 4 * hi;
            const u32x2 sv = *(const u32x2*)(src + (seg == 0 ? (size_t)tok * DM + col : ((size_t)(col >> 7) * NTOK + tok) * 128 + (col & 127)));
            acc[mi][ni][4 * g] = bflo(sv.x) * siluf(acc[mi][ni][4 * g]); acc[mi][ni][4 * g + 1] = bfhi(sv.x) * siluf(acc[mi][ni][4 * g + 1]);
            acc[mi][ni][4 * g + 2] = bflo(sv.y) * siluf(acc[mi][ni][4 * g + 2]); acc[mi][ni][4 * g + 3] = bfhi(sv.y) * siluf(acc[mi][ni][4 * g + 3]); }
          else {
#pragma unroll
            for (int e = 0; e < 4; ++e) acc[mi][ni][4 * g + e] = sigmf(acc[mi][ni][4 * g + e]); } }
    store_rows_bf16(acc, dst, DM, rw, cw, c32, hi);
    mt = mt2; nt = nt2; have = have2;
  }
}
__device__ NOINL void phase3bc(const Params& p) {
  char* lds = g_lds;
  int tid_ = threadIdx.x; asm volatile("" : "+v"(tid_));
  const int tid = tid_, lane = tid & 63, wid = tid >> 6, wm = wid >> 1, wn = wid & 1, c32 = lane & 31, hi = lane >> 5;
  const bf16_t* A2 = (const bf16_t*)(p.ws + OFF_A2); const bf16_t* A3 = (const bf16_t*)(p.ws + OFF_A3);
  const bf16_t* SG = (const bf16_t*)p.out; const bf16_t* SD = SG + (size_t)NTOK * DM; bf16_t* MR = (bf16_t*)(p.ws + OFF_MRG);
  GStage st; st.primed = false;
  int mt, nt; bool have = patch_tile(0, 8, mt, nt);
  for (int rr = 0; have; ++rr) {
    int mt2 = 0, nt2 = 0; const bool have2 = patch_tile(rr + 1, 8, mt2, nt2);
    const int m0 = mt * 256, n0 = nt * 128;
    const bf16_t* H3 = (const bf16_t*)(p.ws + OFF_H3) + (size_t)m0 * DM; const bf16_t* WM = (const bf16_t*)(p.ws + OFF_WP3) + (size_t)(2048 + n0) * DM;
    const int rw = m0 + wm * 64, cw = n0 + wn * 64;
    f32x16 a1[2][2]; unsigned tg[2][2][8], sd[2][2][8];
    const bf16_t* pA2 = A2 + (size_t)m0 * DM; const bf16_t* pWG = (const bf16_t*)(p.ws + OFF_WG) + (size_t)n0 * DM; const bf16_t* pA3 = A3 + (size_t)m0 * DM; const bf16_t* pWD = (const bf16_t*)(p.ws + OFF_WD) + (size_t)n0 * DM;
    zero_acc(a1); gemm_tile<true>(H3, DM, WM, DM, DM, lds, a1, st, pA2, pWG, false);
#pragma unroll
    for (int mi = 0; mi < 2; ++mi)
#pragma unroll
      for (int ni = 0; ni < 2; ++ni)
#pragma unroll
        for (int q = 0; q < 8; ++q) tg[mi][ni][q] = cvtpk(sigmf(a1[mi][ni][2 * q]), sigmf(a1[mi][ni][2 * q + 1]));
    zero_acc(a1); gemm_tile<true>(pA2, DM, pWG, DM, DM, lds, a1, st, H3, WM, false);
#pragma unroll
    for (int mi = 0; mi < 2; ++mi)
#pragma unroll
      for (int ni = 0; ni < 2; ++ni)
#pragma unroll
        for (int q = 0; q < 8; ++q) tg[mi][ni][q] = cvtpk(bflo(tg[mi][ni][q]) * a1[mi][ni][2 * q], bfhi(tg[mi][ni][q]) * a1[mi][ni][2 * q + 1]);
    zero_acc(a1); gemm_tile<true>(H3, DM, WM + (size_t)1024 * DM, DM, DM, lds, a1, st, pA3, pWD, false);
#pragma unroll
    for (int mi = 0; mi < 2; ++mi)
#pragma unroll
      for (int ni = 0; ni < 2; ++ni)
#pragma unroll
        for (int q = 0; q < 8; ++q) sd[mi][ni][q] = cvtpk(sigmf(a1[mi][ni][2 * q]), sigmf(a1[mi][ni][2 * q + 1]));
    zero_acc(a1); gemm_tile<true>(pA3, DM, pWD, DM, DM, lds, a1, st, (const bf16_t*)(p.ws + OFF_H3) + (size_t)(mt2 * 256) * DM, (const bf16_t*)(p.ws + OFF_WP3) + (size_t)(2048 + nt2 * 128) * DM, false);
#pragma unroll
    for (int mi = 0; mi < 2; ++mi)
#pragma unroll
      for (int ni = 0; ni < 2; ++ni)
#pragma unroll
        for (int q = 0; q < 8; ++q) { a1[mi][ni][2 * q] = bflo(tg[mi][ni][q]) + bflo(sd[mi][ni][q]) * a1[mi][ni][2 * q]; a1[mi][ni][2 * q + 1] = bfhi(tg[mi][ni][q]) + bfhi(sd[mi][ni][q]) * a1[mi][ni][2 * q + 1]; }
    store_rows_bf16(a1, MR, DM, rw, cw, c32, hi);
    mt = mt2; nt = nt2; have = have2;
  }
}
__device__ NOINL void phase3d(const Params& p) {
  char* lds = g_lds;
  int tid_ = threadIdx.x; asm volatile("" : "+v"(tid_));
  const int tid = tid_, lane = tid & 63, wid = tid >> 6, wm = wid >> 1, wn = wid & 1, c32 = lane & 31, hi = lane >> 5;
  const bf16_t* MR = (const bf16_t*)(p.ws + OFF_MRG); const float* mod = (const float*)(p.ws + OFF_MOD);
  GStage st; st.primed = false;
  int mt, nt; bool have = patch_tile(0, 8, mt, nt);
  for (int rr = 0; have; ++rr) {
    int mt2 = 0, nt2 = 0; const bool have2 = patch_tile(rr + 1, 8, mt2, nt2);
    const int m0 = mt * 256, n0 = nt * 128;
    f32x16 acc[2][2]; zero_acc(acc);
    gemm_tile<true>(MR + (size_t)m0 * DM, DM, (const bf16_t*)(p.ws + OFF_WO) + (size_t)n0 * DM, DM, DM, lds, acc, st, MR + (size_t)(mt2 * 256) * DM, (const bf16_t*)(p.ws + OFF_WO) + (size_t)(nt2 * 128) * DM, have2);
    const int rw = m0 + wm * 64, cw = n0 + wn * 64, s = seq_of_row(m0);
#pragma unroll
    for (int ni = 0; ni < 2; ++ni)
#pragma unroll
      for (int g = 0; g < 4; ++g) { const int col = cw + ni * 32 + 8 * g + 4 * hi; const f32x4 gt = *(const f32x4*)(mod + s * 3072 + 2048 + col);
#pragma unroll
        for (int mi = 0; mi < 2; ++mi) { const int row = rw + mi * 32 + c32; const f32x4 xv = *(const f32x4*)(xrow(p, row) + col);
          const f32x4 av = {acc[mi][ni][4 * g], acc[mi][ni][4 * g + 1], acc[mi][ni][4 * g + 2], acc[mi][ni][4 * g + 3]};
          *(f32x4*)(p.out + (size_t)row * DM + col) = xv + gt * av; } }
    mt = mt2; nt = nt2; have = have2;
  }
}
__device__ NOINL void phase3e(const Params& p) {
  const int lane = threadIdx.x & 63, wid = threadIdx.x >> 6;
  f32x4 fg[4];
#pragma unroll
  for (int i = 0; i < 4; ++i) fg[i] = *(const f32x4*)(p.final_gain + i * 256 + lane * 4);
  for (int row = blockIdx.x * 8 + wid; row < NTOK; row += gridDim.x * 8) {
    float* o = p.out + (size_t)row * DM; f32x4 v[4]; float ss = 0.f;
#pragma unroll
    for (int i = 0; i < 4; ++i) { v[i] = *(const f32x4*)(o + i * 256 + lane * 4); ss += v[i][0] * v[i][0] + v[i][1] * v[i][1] + v[i][2] * v[i][2] + v[i][3] * v[i][3]; }
#pragma unroll
    for (int m = 1; m < 64; m <<= 1) ss += __shfl_xor(ss, m);
    const float rstd = rsqrtf(ss * (1.f / 1024.f) + EPS);
#pragma unroll
    for (int i = 0; i < 4; ++i) *(f32x4*)(o + i * 256 + lane * 4) = v[i] * rstd * fg[i];
  }
}

constexpr int NPHASE = 9;
__device__ __forceinline__ void gbar(unsigned* ctr, unsigned& epoch) {
  __syncthreads();
  if (threadIdx.x == 0) {
    epoch += gridDim.x;
    __builtin_amdgcn_fence(__ATOMIC_RELEASE, "agent");
    __hip_atomic_fetch_add(ctr, 1u, __ATOMIC_RELAXED, __HIP_MEMORY_SCOPE_AGENT);
    while (__hip_atomic_load(ctr, __ATOMIC_RELAXED, __HIP_MEMORY_SCOPE_AGENT) < epoch) __builtin_amdgcn_s_sleep(1);
    __builtin_amdgcn_fence(__ATOMIC_ACQUIRE, "agent");
  }
  __syncthreads();
}
template <int PB, int PE>
__global__ void __launch_bounds__(NTHR) mega(Params p) {
  char* lds = g_lds;
  unsigned epoch = 0; unsigned* bctr = (unsigned*)(p.ws + OFF_MISC) + 512;
#define PHASE(i, call) if constexpr (PB <= i && i < PE) { call; if constexpr (i + 1 < PE) { if constexpr (i == 0) cg::this_grid().sync(); else gbar(bctr, epoch); } }
  PHASE(0, phase0(p))
  PHASE(1, phase_h<false>(p, (bf16_t*)((char*)p.out + SZ_FULL)))
  PHASE(2, phase1(p))
  PHASE(3, phase2(p))
  PHASE(4, phase_h<true>(p, (bf16_t*)(p.ws + OFF_H3)))
  PHASE(5, phase3a(p))
  PHASE(6, phase3bc(p))
  PHASE(7, phase3d(p))
  PHASE(8, phase3e(p))
#undef PHASE
  (void)lds;
}

extern "C" void kernel_launch(void* const* d_in, const int* in_sizes, int n_in, void* d_out, int out_size, void* d_ws, size_t ws_size, hipStream_t stream) {
  if (n_in != 18 || out_size != NTOK * DM || ws_size < WS_NEED) { fprintf(stderr, "kernel_launch: unexpected shapes (n_in %d out %d ws %zu need %zu)\n", n_in, out_size, ws_size, WS_NEED); return; }
  Params p{};
  p.x_prompt = (const float*)d_in[0]; p.x_sample = (const float*)d_in[1]; p.c_prompt = (const float*)d_in[2]; p.c_sample = (const float*)d_in[3];
  p.w_ada = (const float*)d_in[4]; p.b_ada = (const float*)d_in[5]; p.norm_gain = (const float*)d_in[6]; p.w_in = (const float*)d_in[7];
  p.w_alpha = (const float*)d_in[8]; p.b_alpha = (const float*)d_in[9]; p.gla_norm_gain = (const float*)d_in[10]; p.lambda_q = (const float*)d_in[11];
  p.lambda_k = (const float*)d_in[12]; p.diff_norm_gain = (const float*)d_in[13]; p.w_bo_gla = (const float*)d_in[14]; p.w_bo_diff = (const float*)d_in[15];
  p.w_out = (const float*)d_in[16]; p.final_gain = (const float*)d_in[17]; p.out = (float*)d_out; p.ws = (char*)d_ws;
  static int grid_blocks = 0;
  if (!grid_blocks) { int dev = 0, cus = 0, per_cu = 0; hipGetDevice(&dev); hipDeviceGetAttribute(&cus, hipDeviceAttributeMultiprocessorCount, dev);
    hipOccupancyMaxActiveBlocksPerMultiprocessor(&per_cu, mega<0, NPHASE>, NTHR, 0); if (per_cu < 1) per_cu = 1; grid_blocks = cus * per_cu; }
#if COOP
  void* args[] = {&p};
  hipError_t e = hipLaunchCooperativeKernel((void*)mega<0, NPHASE>, dim3(grid_blocks), dim3(NTHR), args, 0, stream);
  if (e != hipSuccess) fprintf(stderr, "cooperative launch failed: %s (grid %d)\n", hipGetErrorString(e), grid_blocks);
#else
  hipLaunchKernelGGL((mega<0, 1>), dim3(grid_blocks), dim3(NTHR), 0, stream, p);
  hipLaunchKernelGGL((mega<1, 2>), dim3(grid_blocks), dim3(NTHR), 0, stream, p);
  hipLaunchKernelGGL((mega<2, 3>), dim3(grid_blocks), dim3(NTHR), 0, stream, p);
  hipLaunchKernelGGL((mega<3, 4>), dim3(grid_blocks), dim3(NTHR), 0, stream, p);
  hipLaunchKernelGGL((mega<4, 5>), dim3(grid_blocks), dim3(NTHR), 0, stream, p);
  hipLaunchKernelGGL((mega<5, 6>), dim3(grid_blocks), dim3(NTHR), 0, stream, p);
  hipLaunchKernelGGL((mega<6, 7>), dim3(grid_blocks), dim3(NTHR), 0, stream, p);
  hipLaunchKernelGGL((mega<7, 8>), dim3(grid_blocks), dim3(NTHR), 0, stream, p);
  hipLaunchKernelGGL((mega<8, 9>), dim3(grid_blocks), dim3(NTHR), 0, stream, p);
#endif
}
```

```cpp
#include <hip/hip_runtime.h>
#include <hip/hip_cooperative_groups.h>
#include <cstdio>
#include <cstdint>
namespace cg = cooperative_groups;

#ifndef COOP
#define COOP 1
#endif

typedef unsigned short bf16_t;
using bf16x8 = __attribute__((ext_vector_type(8))) short;
using s16x4  = __attribute__((ext_vector_type(4))) short;
using f32x16 = __attribute__((ext_vector_type(16))) float;
using f32x4  = __attribute__((ext_vector_type(4))) float;
using f32x2  = __attribute__((ext_vector_type(2))) float;
using u32x4  = __attribute__((ext_vector_type(4))) unsigned;
using u32x2  = __attribute__((ext_vector_type(2))) unsigned;

constexpr int DM = 1024, LP = 16384, LS = 4096, NSEQ = 9, NTOK = LP + 8 * LS;
constexpr int INC = 9248;
constexpr int NP1 = 5248;
constexpr int NP3 = 4096;
constexpr float EPS = 1e-6f;

constexpr size_t SZ_HALF = (size_t)NTOK * 512 * 2;
constexpr size_t SZ_FULL = (size_t)NTOK * 1024 * 2;
constexpr size_t OFF_GQ = 0, OFF_GK = OFF_GQ + SZ_HALF, OFF_GV = OFF_GK + SZ_HALF, OFF_DQ = OFF_GV + SZ_FULL, OFF_DK = OFF_DQ + SZ_FULL, OFF_DV = OFF_DK + SZ_FULL;
constexpr size_t OFF_LOW = OFF_DV + SZ_FULL, SZ_LOW = (size_t)NTOK * 32 * 4;
constexpr size_t OFF_WP1 = OFF_LOW + SZ_LOW, OFF_WP3 = OFF_WP1 + (size_t)NP1 * 1024 * 2, OFF_WG = OFF_WP3 + (size_t)NP3 * 1024 * 2;
constexpr size_t OFF_WD = OFF_WG + 2097152, OFF_WO = OFF_WD + 2097152, OFF_MOD = OFF_WO + 2097152;
constexpr size_t OFF_ROPE = OFF_MOD + (size_t)NSEQ * 3072 * 4, OFF_MISC = OFF_ROPE + 65536, WS_NEED = OFF_MISC + 4096;
constexpr size_t OFF_H3 = OFF_GQ, OFF_OGN = OFF_GV, OFF_A2 = OFF_DK, OFF_A3 = OFF_DV, OFF_MRG = OFF_GV;

constexpr int LDS_BYTES = 106 * 1024, NTHR = 512;
__shared__ __attribute__((aligned(16))) char g_lds[LDS_BYTES];
#define NOINL __forceinline__

struct Params {
  const float *x_prompt, *x_sample, *c_prompt, *c_sample, *w_ada, *b_ada, *norm_gain, *w_in, *w_alpha, *b_alpha, *gla_norm_gain, *lambda_q, *lambda_k,
      *diff_norm_gain, *w_bo_gla, *w_bo_diff, *w_out, *final_gain;
  float* out; char* ws;
};

typedef __bf16 bf16n2 __attribute__((ext_vector_type(2)));
__device__ __forceinline__ unsigned cvtpk(float lo, float hi) { const f32x2 v = {lo, hi}; const bf16n2 b = __builtin_convertvector(v, bf16n2); return __builtin_bit_cast(unsigned, b); }
__device__ __forceinline__ bf16_t f2bf(float x) { return (bf16_t)(cvtpk(x, 0.f) & 0xffffu); }
__device__ __forceinline__ float bf2f(bf16_t v) { return __uint_as_float((unsigned)v << 16); }
__device__ __forceinline__ float bflo(unsigned w) { return __uint_as_float(w << 16); }
__device__ __forceinline__ float bfhi(unsigned w) { return __uint_as_float(w & 0xffff0000u); }
__device__ __forceinline__ int crow(int r, int hi) { return (r & 3) + 8 * (r >> 2) + 4 * hi; }
__device__ __forceinline__ float siluf(float x) { return x * __builtin_amdgcn_rcpf(1.f + __expf(-x)); }
__device__ __forceinline__ float sigmf(float x) { return __builtin_amdgcn_rcpf(1.f + __expf(-x)); }
__device__ __forceinline__ int seq_of_row(int row) { return row < LP ? 0 : 1 + ((row - LP) >> 12); }
__device__ __forceinline__ int seq_base(int s) { return s == 0 ? 0 : LP + (s - 1) * LS; }
__device__ __forceinline__ int seq_len(int s) { return s == 0 ? LP : LS; }
__device__ __forceinline__ const float* xrow(const Params& p, int row) { return row < LP ? p.x_prompt + (size_t)row * DM : p.x_sample + (size_t)(row - LP) * DM; }

__device__ void sincos_d(double a, double& s, double& c) {
  const double n = rint(a * 0.63661977236758134308);
  double y = a - n * 1.5707963267341256; y -= n * 6.077100506506192e-11;
  const double y2 = y * y;
  double sp = 1.0 / 355687428096000.0;
  sp = sp * y2 - 1.0 / 1307674368000.0; sp = sp * y2 + 1.0 / 6227020800.0; sp = sp * y2 - 1.0 / 39916800.0; sp = sp * y2 + 1.0 / 362880.0;
  sp = sp * y2 - 1.0 / 5040.0; sp = sp * y2 + 1.0 / 120.0; sp = sp * y2 - 1.0 / 6.0; sp = sp * y2 + 1.0; sp *= y;
  double cp = 1.0 / 20922789888000.0;
  cp = cp * y2 - 1.0 / 87178291200.0; cp = cp * y2 + 1.0 / 479001600.0; cp = cp * y2 - 1.0 / 3628800.0; cp = cp * y2 + 1.0 / 40320.0;
  cp = cp * y2 - 1.0 / 720.0; cp = cp * y2 + 1.0 / 24.0; cp = cp * y2 - 0.5; cp = cp * y2 + 1.0;
  const int q = ((int)n) & 3;
  s = (q == 0) ? sp : (q == 1) ? cp : (q == 2) ? -sp : -cp;
  c = (q == 0) ? cp : (q == 1) ? -sp : (q == 2) ? -cp : sp;
}

constexpr int P0_MOD_TASKS = 192;
constexpr int T_WP1 = NP1 / 64  , T_WP3 = NP3 / 64  , T_SQ = 16;
constexpr int P0_TR_TILES = (T_WP1 + T_WP3 + 3 * T_SQ) * 16;
constexpr int P0_TASKS = P0_MOD_TASKS + P0_TR_TILES + 1 + 16;

__device__ void p0_mod_task(const Params& p, int t, char* lds) {
  float* sc = (float*)lds;
  float* red = (float*)(lds + 36864);
  const int tid = threadIdx.x;
  for (int i = tid; i < NSEQ * 1024; i += NTHR) { const int s = i >> 10, k = i & 1023; const float c = s == 0 ? p.c_prompt[k] : p.c_sample[(s - 1) * 1024 + k]; sc[i] = siluf(c); }
  __syncthreads();
  const int col = tid & 15, kp = tid >> 4, n = t * 16 + col;
  float acc[NSEQ];
#pragma unroll
  for (int s = 0; s < NSEQ; ++s) acc[s] = 0.f;
  for (int kk = 0; kk < 32; ++kk) { const int k = kp * 32 + kk; const float w = p.w_ada[(size_t)k * 3072 + n];
#pragma unroll
    for (int s = 0; s < NSEQ; ++s) acc[s] += sc[s * 1024 + k] * w; }
#pragma unroll
  for (int s = 0; s < NSEQ; ++s) red[(kp * NSEQ + s) * 16 + col] = acc[s];
  __syncthreads();
  if (tid < NSEQ * 16) { const int s = tid >> 4, c2 = tid & 15; float a = p.b_ada[t * 16 + c2];
    for (int q = 0; q < 32; ++q) a += red[(q * NSEQ + s) * 16 + c2];
    ((float*)(p.ws + OFF_MOD))[s * 3072 + t * 16 + c2] = a; }
  __syncthreads();
}

__device__ void p0_tr_tile(const float* src, int ld, int c0, int nvalid, bf16_t* dst, int n0, int k0, char* lds) {
  bf16_t* tile = (bf16_t*)lds;
  const int tid = threadIdx.x, kr = tid >> 4, c4 = (tid & 15) * 4;
#pragma unroll
  for (int i = 0; i < 2; ++i) { const int k = kr + 32 * i; f32x4 v = {0.f, 0.f, 0.f, 0.f};
    if (c4 < nvalid) v = *(const f32x4*)(src + (size_t)(k0 + k) * ld + c0 + c4);
    tile[(c4 + 0) * 72 + k] = f2bf(v[0]); tile[(c4 + 1) * 72 + k] = f2bf(v[1]); tile[(c4 + 2) * 72 + k] = f2bf(v[2]); tile[(c4 + 3) * 72 + k] = f2bf(v[3]); }
  __syncthreads();
  { const int n = tid >> 3, kq = (tid & 7) * 8;
    const u32x4 a = *(const u32x4*)(tile + n * 72 + kq);
    bf16_t* d = dst + (size_t)(n0 + n) * 1024 + k0 + kq; *(u32x4*)d = a; }
  __syncthreads();
}

__device__ NOINL void phase0(const Params& p) {
  char* lds = g_lds;
  for (int t = blockIdx.x; t < P0_TASKS; t += gridDim.x) {
    if (t < P0_MOD_TASKS) { p0_mod_task(p, t, lds); continue; }
    int u = t - P0_MOD_TASKS;
    if (u < P0_TR_TILES) {
      const int kt = u & 15; int ct = u >> 4;
      if (ct < T_WP1) { const int n0 = ct * 64; int c0, nv = 64;
        if (n0 < 2048) c0 = n0; else if (n0 < 5120) c0 = 3104 + (n0 - 2048); else if (n0 < 5184) { c0 = 3072; nv = 32; } else { c0 = 0; nv = 0; }
        p0_tr_tile(p.w_in, INC, c0, nv, (bf16_t*)(p.ws + OFF_WP1), n0, kt * 64, lds); continue; }
      ct -= T_WP1;
      if (ct < T_WP3) { const int n0 = ct * 64; const int c0 = n0 < 1024 ? 2048 + n0 : n0 < 2048 ? 6176 + (n0 - 1024) : 7200 + (n0 - 2048);
        p0_tr_tile(p.w_in, INC, c0, 64, (bf16_t*)(p.ws + OFF_WP3), n0, kt * 64, lds); continue; }
      ct -= T_WP3;
      const int which = ct >> 4, n0 = (ct & 15) * 64;
      const float* src = which == 0 ? p.w_bo_gla : which == 1 ? p.w_bo_diff : p.w_out;
      bf16_t* dst = (bf16_t*)(p.ws + (which == 0 ? OFF_WG : which == 1 ? OFF_WD : OFF_WO));
      p0_tr_tile(src, 1024, n0, 64, dst, n0, kt * 64, lds); continue;
    }
    u -= P0_TR_TILES;
    if (u == 0) {
      if (threadIdx.x == 0) { float a = 0.f, b = 0.f; for (int i = 0; i < 64; ++i) { a += p.lambda_q[i] * p.lambda_k[i]; b += p.lambda_q[64 + i] * p.lambda_k[64 + i]; }
        float* misc = (float*)(p.ws + OFF_MISC); misc[0] = expf(a) - expf(b) + 0.2f; for (int q = 0; q < 8; ++q) ((unsigned*)misc)[64 + q * 32] = 0u; ((unsigned*)misc)[512] = 0u; }
      continue; }
    u -= 1;
    { const int idx = u * NTHR + threadIdx.x, tab = idx >> 12, a = (idx >> 5) & 127, i = idx & 31;
      double inv = 1.0; for (int q = 0; q < i; ++q) inv *= 0.7498942093324558;
      const double ang = (tab == 0 ? 128.0 * (double)a : (double)a) * inv; double s, c; sincos_d(ang, s, c);
      ((f32x2*)(p.ws + OFF_ROPE))[idx] = (f32x2){(float)c, (float)s}; }
  }
}

template <bool WITH_OGN>
__device__ NOINL void phase_h(const Params& p, bf16_t* hdst) {
  const int lane = threadIdx.x & 63, wid = threadIdx.x >> 6;
  const float* mod = (const float*)(p.ws + OFF_MOD);
  int scur = -1; f32x4 ca[4], cb[4];
  f32x4 gg0 = {0.f, 0.f, 0.f, 0.f}, gg1 = gg0;
  if constexpr (WITH_OGN) { gg0 = *(const f32x4*)(p.gla_norm_gain + ((lane * 8) & 255)); gg1 = *(const f32x4*)(p.gla_norm_gain + ((lane * 8) & 255) + 4); }
  for (int row = blockIdx.x * 8 + wid; row < NTOK; row += gridDim.x * 8) {
    const float* x = xrow(p, row); const int s = seq_of_row(row);
    f32x4 v[4]; float ss = 0.f;
#pragma unroll
    for (int i = 0; i < 4; ++i) { v[i] = __builtin_nontemporal_load((const f32x4*)(x + i * 256 + lane * 4)); ss += v[i][0] * v[i][0] + v[i][1] * v[i][1] + v[i][2] * v[i][2] + v[i][3] * v[i][3]; }
#pragma unroll
    for (int m = 1; m < 64; m <<= 1) ss += __shfl_xor(ss, m);
    const float rstd = rsqrtf(ss * (1.f / 1024.f) + EPS);
    if (s != scur) { scur = s;
#pragma unroll
      for (int i = 0; i < 4; ++i) { const int c = i * 256 + lane * 4;
        const f32x4 g = *(const f32x4*)(p.norm_gain + c), sh = *(const f32x4*)(mod + s * 3072 + c), sc = *(const f32x4*)(mod + s * 3072 + 1024 + c);
        ca[i] = g * (1.f + sc); cb[i] = sh; } }
#pragma unroll
    for (int i = 0; i < 4; ++i) { const int c = i * 256 + lane * 4;
      const f32x4 h = v[i] * rstd * ca[i] + cb[i];
      u32x2 w; w.x = cvtpk(h[0], h[1]); w.y = cvtpk(h[2], h[3]); *(u32x2*)(hdst + (size_t)row * DM + c) = w; }
    if constexpr (WITH_OGN) {
      const bf16_t* of = (const bf16_t*)p.out + (size_t)row * DM; const bf16_t* ob = of + (size_t)NTOK * DM;
      bf16_t* ogn = (bf16_t*)(p.ws + OFF_OGN) + (size_t)row * DM;
#pragma unroll
      for (int i = 0; i < 2; ++i) { const int c = i * 512 + lane * 8;
        const u32x4 a = *(const u32x4*)(of + c), b = *(const u32x4*)(ob + c); float o[8]; float q = 0.f;
#pragma unroll
        for (int e = 0; e < 4; ++e) { o[2 * e] = bflo(a[e]) + bflo(b[e]); o[2 * e + 1] = bfhi(a[e]) + bfhi(b[e]); q += o[2 * e] * o[2 * e] + o[2 * e + 1] * o[2 * e + 1]; }
#pragma unroll
        for (int m = 1; m < 32; m <<= 1) q += __shfl_xor(q, m);
        const float r = rsqrtf(q * (1.f / 256.f) + EPS);
        const f32x4 g0 = gg0, g1 = gg1;
        u32x4 w; w.x = cvtpk(o[0] * r * g0[0], o[1] * r * g0[1]); w.y = cvtpk(o[2] * r * g0[2], o[3] * r * g0[3]);
        w.z = cvtpk(o[4] * r * g1[0], o[5] * r * g1[1]); w.w = cvtpk(o[6] * r * g1[2], o[7] * r * g1[3]);
        *(u32x4*)(ogn + c) = w; }
    }
  }
}

__device__ __forceinline__ int gsw(int row, int ch) { return row * 128 + ((ch ^ ((row >> 1) & 7)) << 4); }
template <bool SWAP>
__device__ __forceinline__ void gemm_tile(const bf16_t* __restrict__ A, int lda, const bf16_t* __restrict__ Bt, int ldb, int K, char* lds, f32x16 (&acc)[2][2]) {
  int tid_ = threadIdx.x; asm volatile("" : "+v"(tid_));
  const int tid = tid_, lane = tid & 63, wid = tid >> 6, wm = wid >> 1, wn = wid & 1, c32 = lane & 31, hi = lane >> 5;
  const int srow = tid >> 3, sch = tid & 7;
  const bf16_t* ga = A + (size_t)srow * lda + sch * 8; const bf16_t* gb = Bt + (size_t)srow * ldb + sch * 8;
  bf16x8 ra[4], rb[2];
  const int nk = K >> 6;
#define G_LOAD(kt) do { _Pragma("unroll") for (int i = 0; i < 4; ++i) ra[i] = *(const bf16x8*)(ga + (size_t)(64 * i) * lda + (kt) * 64); \
    _Pragma("unroll") for (int i = 0; i < 2; ++i) rb[i] = *(const bf16x8*)(gb + (size_t)(64 * i) * ldb + (kt) * 64); } while (0)
#define G_WRITE(buf) do { char* sA_ = lds + (buf) * 49152; char* sB_ = sA_ + 32768; \
    _Pragma("unroll") for (int i = 0; i < 4; ++i) *(bf16x8*)(sA_ + gsw(srow + 64 * i, sch)) = ra[i]; \
    _Pragma("unroll") for (int i = 0; i < 2; ++i) *(bf16x8*)(sB_ + gsw(srow + 64 * i, sch)) = rb[i]; } while (0)
  G_LOAD(0);
  __syncthreads();
  G_WRITE(0);
  if (nk > 1) G_LOAD(1);
  __syncthreads();
  for (int kt = 0; kt < nk; ++kt) {
    const int cur = kt & 1;
    const char* sA = lds + cur * 49152; const char* sB = sA + 32768;
#define G_FRAG(FA, FB, ks) do { _Pragma("unroll") for (int i = 0; i < 2; ++i) { FA[i] = *(const bf16x8*)(sA + gsw(wm * 64 + i * 32 + c32, (ks) * 2 + hi)); FB[i] = *(const bf16x8*)(sB + gsw(wn * 64 + i * 32 + c32, (ks) * 2 + hi)); } } while (0)
#define G_MMA4(FA, FB) do { _Pragma("unroll") for (int mi = 0; mi < 2; ++mi) _Pragma("unroll") for (int ni = 0; ni < 2; ++ni) \
      acc[mi][ni] = SWAP ? __builtin_amdgcn_mfma_f32_32x32x16_bf16(FB[ni], FA[mi], acc[mi][ni], 0, 0, 0) : __builtin_amdgcn_mfma_f32_32x32x16_bf16(FA[mi], FB[ni], acc[mi][ni], 0, 0, 0); } while (0)
    { bf16x8 fa0[2], fb0[2], fa1[2], fb1[2];
      G_FRAG(fa0, fb0, 0); G_FRAG(fa1, fb1, 1); __builtin_amdgcn_sched_barrier(0);
      G_MMA4(fa0, fb0); __builtin_amdgcn_sched_barrier(0);
      if (kt + 1 < nk) { G_WRITE(cur ^ 1); if (kt + 2 < nk) G_LOAD(kt + 2); }
      G_FRAG(fa0, fb0, 2); __builtin_amdgcn_sched_barrier(0);
      G_MMA4(fa1, fb1); __builtin_amdgcn_sched_barrier(0);
      G_FRAG(fa1, fb1, 3); __builtin_amdgcn_sched_barrier(0);
      G_MMA4(fa0, fb0); __builtin_amdgcn_sched_barrier(0);
      G_MMA4(fa1, fb1); }
#undef G_FRAG
#undef G_MMA4
    __syncthreads();
  }
#undef G_LOAD
#undef G_WRITE
}
__device__ __forceinline__ void zero_acc(f32x16 (&acc)[2][2]) {
#pragma unroll
  for (int a = 0; a < 2; ++a)
#pragma unroll
    for (int b = 0; b < 2; ++b)
#pragma unroll
      for (int r = 0; r < 16; ++r) acc[a][b][r] = 0.f;
}
__device__ __forceinline__ void store_rows_bf16(const f32x16 (&acc)[2][2], bf16_t* dst, int ld, int tok0, int col0, int c32, int hi) {
#pragma unroll
  for (int mi = 0; mi < 2; ++mi)
#pragma unroll
    for (int ni = 0; ni < 2; ++ni)
#pragma unroll
      for (int g = 0; g < 4; g += 2) { const f32x16& v = acc[mi][ni];
        const unsigned x0 = cvtpk(v[4 * g], v[4 * g + 1]), x1 = cvtpk(v[4 * g + 2], v[4 * g + 3]), y0 = cvtpk(v[4 * g + 4], v[4 * g + 5]), y1 = cvtpk(v[4 * g + 6], v[4 * g + 7]);
        auto r0 = __builtin_amdgcn_permlane32_swap(x0, y0, false, false); auto r1 = __builtin_amdgcn_permlane32_swap(x1, y1, false, false);
        const u32x4 w = {r0[0], r1[0], r0[1], r1[1]};
        *(u32x4*)(dst + (size_t)(tok0 + mi * 32 + c32) * ld + col0 + ni * 32 + 8 * (g + hi)) = w; }
}

__device__ __forceinline__ bool patch_tile(int r, int NT, int& mt, int& nt) {
  const int nb = gridDim.x, per = nb >> 3, b = blockIdx.x;
  const int t = (nb & 7) ? r * nb + b : r * nb + (b & 7) * per + (b >> 3);
  if (t >= (NTOK / 256) * NT) return false;
  const int gsz = 4 * NT, grp = t / gsz, rem = t - grp * gsz; nt = rem >> 2; mt = grp * 4 + (rem & 3); return true;
}
__device__ NOINL void phase1(const Params& p) {
  char* lds = g_lds;
  int tid_ = threadIdx.x; asm volatile("" : "+v"(tid_));
  const int tid = tid_, lane = tid & 63, wid = tid >> 6, wm = wid >> 1, wn = wid & 1, c32 = lane & 31, hi = lane >> 5;
  const bf16_t* H = (const bf16_t*)((const char*)p.out + SZ_FULL);
  const bf16_t* W = (const bf16_t*)(p.ws + OFF_WP1);
  const f32x2* ropeHi = (const f32x2*)(p.ws + OFF_ROPE); const f32x2* ropeLo = ropeHi + 4096;
  constexpr int NT = NP1 / 128;
  for (int rr = 0;; ++rr) {
    int mt, nt; if (!patch_tile(rr, NT, mt, nt)) break;
    const int m0 = mt * 256, n0 = nt * 128;
    f32x16 acc[2][2]; zero_acc(acc);
    const int rw = m0 + wm * 64, cw = n0 + wn * 64;
    if (nt >= 8 && nt < 16) {
      gemm_tile<false>(H + (size_t)m0 * DM, DM, W + (size_t)n0 * DM, DM, DM, lds, acc);
      bf16_t* dst = (bf16_t*)(p.ws + OFF_GV); const int cb = cw - 1024;
#pragma unroll
      for (int mi = 0; mi < 2; ++mi)
#pragma unroll
        for (int ni = 0; ni < 2; ++ni)
#pragma unroll
          for (int q = 0; q < 4; ++q) { u32x2 w; w.x = cvtpk(acc[mi][ni][4 * q], acc[mi][ni][4 * q + 1]); w.y = cvtpk(acc[mi][ni][4 * q + 2], acc[mi][ni][4 * q + 3]);
            *(u32x2*)(dst + (size_t)(cb + ni * 32 + c32) * NTOK + rw + mi * 32 + 8 * q + 4 * hi) = w; }
      continue;
    }
    gemm_tile<true>(H + (size_t)m0 * DM, DM, W + (size_t)n0 * DM, DM, DM, lds, acc);
    if (nt < 8) {
      if (nt < 4) {
#pragma unroll
        for (int mi = 0; mi < 2; ++mi)
#pragma unroll
          for (int ni = 0; ni < 2; ++ni) acc[mi][ni] = acc[mi][ni] * 0.08838834764831845f;
        store_rows_bf16(acc, (bf16_t*)(p.ws + OFF_GQ), 512, rw, cw, c32, hi);
      } else store_rows_bf16(acc, (bf16_t*)(p.ws + OFF_GK), 512, rw, cw - 512, c32, hi);
    } else if (nt < 32) {
      const int pos0 = m0 < LP ? m0 : (m0 & (LS - 1));
      const float qsc = nt < 24 ? 0.18033688011112042f : 1.f;
      const f32x2* thp = ropeHi + ((pos0 >> 7) + (wm >> 1)) * 32 + 4 * hi;
#pragma unroll
      for (int mi = 0; mi < 2; ++mi) { const f32x2* tlp = ropeLo + ((wm * 64 + mi * 32 + c32) & 127) * 32 + 4 * hi;
#pragma unroll
        for (int g = 0; g < 4; ++g) { const f32x4 ta = *(const f32x4*)(thp + 8 * g), tb = *(const f32x4*)(thp + 8 * g + 2), la = *(const f32x4*)(tlp + 8 * g), lb = *(const f32x4*)(tlp + 8 * g + 2);
          const float thx[4] = {ta[0], ta[2], tb[0], tb[2]}, thy[4] = {ta[1], ta[3], tb[1], tb[3]}, tlx[4] = {la[0], la[2], lb[0], lb[2]}, tly[4] = {la[1], la[3], lb[1], lb[3]};
#pragma unroll
          for (int e = 0; e < 4; ++e) { const int r = 4 * g + e; const float c = thx[e] * tlx[e] - thy[e] * tly[e], s = thy[e] * tlx[e] + thx[e] * tly[e];
            const float x1 = acc[mi][0][r] * qsc, x2 = acc[mi][1][r] * qsc; acc[mi][0][r] = x1 * c - x2 * s; acc[mi][1][r] = x1 * s + x2 * c; } } }
      { const int cb = cw - (nt < 24 ? 2048 : 3072);
        store_rows_bf16(acc, (bf16_t*)(p.ws + (nt < 24 ? OFF_DQ : OFF_DK)) + (size_t)(cb >> 7) * NTOK * 128, 128, rw, cb & 127, c32, hi); }
    } else if (nt < 40) {
      { const int cb = cw - 4096; store_rows_bf16(acc, (bf16_t*)(p.ws + OFF_DV) + (size_t)(cb >> 7) * NTOK * 128, 128, rw, cb & 127, c32, hi); }
    } else if (wn == 0) {
      float* dst = (float*)(p.ws + OFF_LOW);
#pragma unroll
      for (int mi = 0; mi < 2; ++mi)
#pragma unroll
        for (int g = 0; g < 4; ++g) *(f32x4*)(dst + (size_t)(rw + mi * 32 + c32) * 32 + 8 * g + 4 * hi) = (f32x4){acc[mi][0][4 * g], acc[mi][0][4 * g + 1], acc[mi][0][4 * g + 2], acc[mi][0][4 * g + 3]};
    }
  }
}

constexpr int GQT = 0, GKT = 17408, GKH = 34816, GVT = 53248, GSC = 90112, GLWA = 99328, GDEC = 104448, GLA_LDS = 104960;
constexpr int QROW = 272, HROW = 144, LROW = 80;
__device__ __forceinline__ unsigned rot16(unsigned x) { return (x >> 16) | (x << 16); }

__device__ __forceinline__ void gla_item(const Params& p, int s, int hh, int dir, char* lds) {
  int tid_ = threadIdx.x; asm volatile("" : "+v"(tid_));
  const int tid = tid_, lane = tid & 63, wid = __builtin_amdgcn_readfirstlane(tid >> 6), n16 = lane & 15, g4 = lane >> 4;
  const int base = seq_base(s), L = seq_len(s), nchunk = L >> 6;
  const bf16_t* GQ = (const bf16_t*)(p.ws + OFF_GQ) + hh * 128; const bf16_t* GK = (const bf16_t*)(p.ws + OFF_GK) + hh * 128;
  const bf16_t* GVg = (const bf16_t*)(p.ws + OFF_GV) + (size_t)(hh * 256) * NTOK; const float* LOW = (const float*)(p.ws + OFF_LOW) + dir * 16;
  bf16_t* OUT = (bf16_t*)p.out + (size_t)dir * NTOK * DM + hh * 256 + wid * 32;
  bf16x8 B1, B2; float ba;
  { const int d = hh * 128 + wid * 16 + n16; float wh[8], wl[8];
#pragma unroll
    for (int e = 0; e < 8; ++e) { const float w = p.w_alpha[(size_t)(dir * 16 + (g4 & 1) * 8 + e) * 512 + d]; const float h = bf2f(f2bf(w)); wh[e] = h; wl[e] = (g4 < 2) ? (w - h) : 0.f; }
    u32x4 a = {cvtpk(wh[0], wh[1]), cvtpk(wh[2], wh[3]), cvtpk(wh[4], wh[5]), cvtpk(wh[6], wh[7])}; B1 = *(bf16x8*)&a;
    u32x4 c = {cvtpk(wl[0], wl[1]), cvtpk(wl[2], wl[3]), cvtpk(wl[4], wl[5]), cvtpk(wl[6], wl[7])}; B2 = *(bf16x8*)&c;
    ba = p.b_alpha[dir * 512 + d]; }
  f32x4 S[2][8];
#pragma unroll
  for (int nb = 0; nb < 2; ++nb)
#pragma unroll
    for (int b = 0; b < 8; ++b) S[nb][b] = (f32x4){0.f, 0.f, 0.f, 0.f};
  bf16x8 rq[2], rk[2]; u32x4 rv[4]; f32x4 rl = {0.f, 0.f, 0.f, 0.f};
#define GLA_TOK0(c) (dir == 0 ? (c) * 64 : L - 64 * ((c) + 1))
#define GLA_LOAD(c) do { const size_t r0 = (size_t)(base + GLA_TOK0(c)); \
    _Pragma("unroll") for (int i = 0; i < 2; ++i) { const int id = tid + NTHR * i, j = id >> 4, ch = id & 15; rq[i] = *(const bf16x8*)(GQ + (r0 + j) * 512 + ch * 8); rk[i] = *(const bf16x8*)(GK + (r0 + j) * 512 + ch * 8); } \
    _Pragma("unroll") for (int i = 0; i < 4; ++i) { const int id = tid + NTHR * i, e = id >> 3, jq = id & 7; rv[i] = *(const u32x4*)(GVg + (size_t)e * NTOK + r0 + jq * 8); } \
    if (tid < 256) { const int j = tid >> 2, pt = tid & 3; rl = *(const f32x4*)(LOW + (r0 + j) * 32 + pt * 4); } } while (0)
  GLA_LOAD(0);
  for (int c = 0; c < nchunk; ++c) {
    __syncthreads();
#pragma unroll
    for (int i = 0; i < 2; ++i) { const int id = tid + NTHR * i, jm = id >> 4, ch = id & 15, j = dir ? 63 - jm : jm;
      *(bf16x8*)(lds + GQT + j * QROW + ch * 16) = rq[i]; *(bf16x8*)(lds + GKT + j * QROW + ch * 16) = rk[i]; }
#pragma unroll
    for (int i = 0; i < 4; ++i) { const int id = tid + NTHR * i, e = id >> 3, jq = id & 7; u32x4 w = rv[i];
      if (dir) { w = (u32x4){rot16(rv[i].w), rot16(rv[i].z), rot16(rv[i].y), rot16(rv[i].x)}; }
      *(u32x4*)(lds + GVT + e * HROW + (dir ? 7 - jq : jq) * 16) = w; }
    if (tid < 256) { const int jm = tid >> 2, pt = tid & 3, j = dir ? 63 - jm : jm;
      const float h0 = bf2f(f2bf(rl[0])), h1 = bf2f(f2bf(rl[1])), h2 = bf2f(f2bf(rl[2])), h3 = bf2f(f2bf(rl[3]));
      u32x2 wh = {cvtpk(h0, h1), cvtpk(h2, h3)}, wl = {cvtpk(rl[0] - h0, rl[1] - h1), cvtpk(rl[2] - h2, rl[3] - h3)};
      *(u32x2*)(lds + GLWA + j * LROW + pt * 8) = wh; *(u32x2*)(lds + GLWA + j * LROW + 32 + pt * 8) = wl; }
    __syncthreads();
    if (c + 1 < nchunk) GLA_LOAD(c + 1);
    {
      float bb[16]; float carry = 0.f;
#pragma unroll
      for (int jb = 0; jb < 4; ++jb) {
        const bf16x8 la = *(const bf16x8*)(lds + GLWA + (jb * 16 + n16) * LROW + g4 * 16);
        f32x4 x = {ba, ba, ba, ba};
        x = __builtin_amdgcn_mfma_f32_16x16x32_bf16(la, B1, x, 0, 0, 0); x = __builtin_amdgcn_mfma_f32_16x16x32_bf16(la, B2, x, 0, 0, 0);
        float sc4[4]; float run = 0.f;
#pragma unroll
        for (int r = 0; r < 4; ++r) { const float lg = x[r]; run += (fminf(lg, 0.f) - __logf(1.f + __expf(-fabsf(lg)))) * 0.0625f; sc4[r] = run; }
        float inc = run; float u = __shfl_up(inc, 16); if (g4 >= 1) inc += u; u = __shfl_up(inc, 32); if (g4 >= 2) inc += u;
        const float ex = carry + (inc - run);
#pragma unroll
        for (int r = 0; r < 4; ++r) bb[jb * 4 + r] = ex + sc4[r];
        carry += __shfl(inc, 48 + n16);
      }
      const float eblast = __expf(carry); const int d = wid * 16 + n16;
      if (g4 == 0) ((float*)(lds + GDEC))[d] = eblast;
#pragma unroll
      for (int jb = 0; jb < 4; ++jb) { float kh[4];
#pragma unroll
        for (int r = 0; r < 4; ++r) { const int j = jb * 16 + g4 * 4 + r; const float b = bb[jb * 4 + r], e1 = __expf(b), e2 = __expf(-b);
          bf16_t* qp = (bf16_t*)(lds + GQT + j * QROW + d * 2); bf16_t* kp = (bf16_t*)(lds + GKT + j * QROW + d * 2);
          const float qv = bf2f(*qp), kv = bf2f(*kp); *qp = f2bf(qv * e1); const float kt = kv * e2; *kp = f2bf(kt); kh[r] = kt * eblast; }
        u32x2 w = {cvtpk(kh[0], kh[1]), cvtpk(kh[2], kh[3])};
        *(u32x2*)(lds + GKH + d * HROW + (jb * 16 + g4 * 4) * 2) = w; }
    }
    __syncthreads();
    {
      const int ib = wid >> 1;
      bf16x8 aq[4];
#pragma unroll
      for (int ks = 0; ks < 4; ++ks) aq[ks] = *(const bf16x8*)(lds + GQT + (ib * 16 + n16) * QROW + (ks * 32 + g4 * 8) * 2);
#pragma unroll
      for (int jj = 0; jj < 2; ++jj) { const int jb = (wid & 1) * 2 + jj; f32x4 a = {0.f, 0.f, 0.f, 0.f};
        if (jb <= ib) {
#pragma unroll
          for (int ks = 0; ks < 4; ++ks) { const bf16x8 bk = *(const bf16x8*)(lds + GKT + (jb * 16 + n16) * QROW + (ks * 32 + g4 * 8) * 2);
            a = __builtin_amdgcn_mfma_f32_16x16x32_bf16(aq[ks], bk, a, 0, 0, 0); } }
#pragma unroll
        for (int r = 0; r < 4; ++r) { float v = a[r]; if (jb == ib && n16 > g4 * 4 + r) v = 0.f;
          *(bf16_t*)(lds + GSC + (ib * 16 + g4 * 4 + r) * HROW + (jb * 16 + n16) * 2) = f2bf(v); } }
    }
    __syncthreads();
    {
      bf16x8 sb[2][4];
#pragma unroll
      for (int nb = 0; nb < 2; ++nb)
#pragma unroll
        for (int ks = 0; ks < 4; ++ks) { u32x4 w; w.x = cvtpk(S[nb][2 * ks][0], S[nb][2 * ks][1]); w.y = cvtpk(S[nb][2 * ks][2], S[nb][2 * ks][3]);
          w.z = cvtpk(S[nb][2 * ks + 1][0], S[nb][2 * ks + 1][1]); w.w = cvtpk(S[nb][2 * ks + 1][2], S[nb][2 * ks + 1][3]); sb[nb][ks] = *(bf16x8*)&w; }
      bf16x8 vf[2][2];
#pragma unroll
      for (int nb = 0; nb < 2; ++nb)
#pragma unroll
        for (int k2 = 0; k2 < 2; ++k2) vf[nb][k2] = *(const bf16x8*)(lds + GVT + (wid * 32 + nb * 16 + n16) * HROW + (k2 * 32 + g4 * 8) * 2);
      const size_t r0 = (size_t)(base + GLA_TOK0(c));
#pragma unroll
      for (int ib = 0; ib < 4; ++ib) { f32x4 o[2] = {{0.f, 0.f, 0.f, 0.f}, {0.f, 0.f, 0.f, 0.f}};
#pragma unroll
        for (int ks = 0; ks < 4; ++ks) { const char* qp = lds + GQT + (ib * 16 + n16) * QROW + (ks * 32 + g4 * 4) * 2;
          const u32x2 lo = *(const u32x2*)qp, hi2 = *(const u32x2*)(qp + 32); u32x4 w = {lo.x, lo.y, hi2.x, hi2.y}; const bf16x8 a = *(bf16x8*)&w;
          o[0] = __builtin_amdgcn_mfma_f32_16x16x32_bf16(sb[0][ks], a, o[0], 0, 0, 0); o[1] = __builtin_amdgcn_mfma_f32_16x16x32_bf16(sb[1][ks], a, o[1], 0, 0, 0); }
#pragma unroll
        for (int k2 = 0; k2 < 2; ++k2) { const bf16x8 a = *(const bf16x8*)(lds + GSC + (ib * 16 + n16) * HROW + (k2 * 32 + g4 * 8) * 2);
          o[0] = __builtin_amdgcn_mfma_f32_16x16x32_bf16(vf[0][k2], a, o[0], 0, 0, 0); o[1] = __builtin_amdgcn_mfma_f32_16x16x32_bf16(vf[1][k2], a, o[1], 0, 0, 0); }
        { const int j = ib * 16 + n16; const size_t row = r0 + (dir ? 63 - j : j);
          u32x2 w0 = {cvtpk(o[0][0], o[0][1]), cvtpk(o[0][2], o[0][3])}, w1 = {cvtpk(o[1][0], o[1][1]), cvtpk(o[1][2], o[1][3])};
          *(u32x2*)(OUT + row * DM + g4 * 4) = w0; *(u32x2*)(OUT + row * DM + 16 + g4 * 4) = w1; } }
      const float* dec = (const float*)(lds + GDEC);
#pragma unroll
      for (int b = 0; b < 8; ++b) { const f32x4 dc = *(const f32x4*)(dec + b * 16 + g4 * 4);
        S[0][b] = S[0][b] * dc; S[1][b] = S[1][b] * dc;
#pragma unroll
        for (int k2 = 0; k2 < 2; ++k2) { const bf16x8 a = *(const bf16x8*)(lds + GKH + (b * 16 + n16) * HROW + (k2 * 32 + g4 * 8) * 2);
          S[0][b] = __builtin_amdgcn_mfma_f32_16x16x32_bf16(a, vf[0][k2], S[0][b], 0, 0, 0); S[1][b] = __builtin_amdgcn_mfma_f32_16x16x32_bf16(a, vf[1][k2], S[1][b], 0, 0, 0); } }
    }
  }
  __syncthreads();
#undef GLA_LOAD
#undef GLA_TOK0
}

constexpr int SHM_V = 16384, SHM_K = 16384, ATT_LDS = 2 * SHM_V + 2 * SHM_K + 8 * 512;
#define KSWZ(row, colB) ((row) * 256 + ((colB) ^ (((row) & 15) << 4)))
#define SBAR() __builtin_amdgcn_sched_barrier(0)
constexpr float ATT_SCALE = 0.125f, ATT_THR = 8.f;
constexpr float ATT_THR2 = ATT_THR * 1.4426950408889634f;
__device__ __forceinline__ void partialSM(f32x16& p0, f32x16& p1, float& m_reg, float& alpha, f32x16& negv, bool first) {
  float tmax = p0[0];
#pragma unroll
  for (int r = 1; r < 16; ++r) tmax = fmaxf(tmax, p0[r]);
#pragma unroll
  for (int r = 0; r < 16; ++r) tmax = fmaxf(tmax, p1[r]);
  { auto rr = __builtin_amdgcn_permlane32_swap(__float_as_uint(tmax), __float_as_uint(tmax), false, false); tmax = fmaxf(__uint_as_float(rr[0]), __uint_as_float(rr[1])); }
  alpha = 1.f;
  if (__builtin_expect(first || !__all(tmax <= ATT_THR2), 0)) {
    const float d = first ? tmax : fmaxf(tmax, 0.f);
    if (!first) alpha = __builtin_amdgcn_exp2f(-d);
    m_reg += d;
#pragma unroll
    for (int r = 0; r < 16; ++r) { p0[r] -= d; p1[r] -= d; negv[r] = -m_reg; }
  }
#pragma unroll
  for (int r = 0; r < 16; ++r) { p0[r] = __builtin_amdgcn_exp2f(p0[r]); p1[r] = __builtin_amdgcn_exp2f(p1[r]); }
}
__device__ __forceinline__ void finishSM(const f32x16& p0, const f32x16& p1, float alpha, float& l_reg, bf16x8& pa0, bf16x8& pa1, bf16x8& pa2, bf16x8& pa3) {
  float ps = 0.f;
#pragma unroll
  for (int r = 0; r < 16; ++r) ps += p0[r] + p1[r];
  { auto rr = __builtin_amdgcn_permlane32_swap(__float_as_uint(ps), __float_as_uint(ps), false, false); ps = __uint_as_float(rr[0]) + __uint_as_float(rr[1]); }
  l_reg = l_reg * alpha + ps;
#define PK4(P, BASE, OUTV) do { unsigned a0 = cvtpk(P[BASE + 0], P[BASE + 1]), a1 = cvtpk(P[BASE + 2], P[BASE + 3]);   \
    unsigned b0 = cvtpk(P[BASE + 4], P[BASE + 5]), b1 = cvtpk(P[BASE + 6], P[BASE + 7]);                              \
    auto r0 = __builtin_amdgcn_permlane32_swap(a0, b0, false, false); auto r1 = __builtin_amdgcn_permlane32_swap(a1, b1, false, false); \
    u32x4 w = {r0[0], r1[0], r0[1], r1[1]}; OUTV = *reinterpret_cast<bf16x8*>(&w); } while (0)
  PK4(p0, 0, pa0); PK4(p0, 8, pa1); PK4(p1, 0, pa2); PK4(p1, 8, pa3);
#undef PK4
}
__device__ __forceinline__ void qkt(f32x16& p0, f32x16& p1, const char* Ks, const bf16x8* qr, int r32, int hi, int z, const f32x16& negv) {
  p0 = negv; p1 = negv;
#pragma unroll
  for (int d0 = 0; d0 < 4; ++d0) { const int cb = ((z * 4 + d0) * 16 + hi * 8) * 2;
    const bf16x8 b0 = *reinterpret_cast<const bf16x8*>(Ks + KSWZ(r32, cb)); const bf16x8 b1 = *reinterpret_cast<const bf16x8*>(Ks + KSWZ(32 + r32, cb));
    p0 = __builtin_amdgcn_mfma_f32_32x32x16_bf16(b0, qr[d0], p0, 0, 0, 0); p1 = __builtin_amdgcn_mfma_f32_32x32x16_bf16(b1, qr[d0], p1, 0, 0, 0); }
}
__device__ __forceinline__ int v_st(int k, int c) { const int kk = (k & ~0xC) | ((k & 4) << 1) | ((k & 8) >> 1); return ((kk >> 3) * 4 + (c >> 5)) * 512 + ((kk & 7) * 32 + (c & 31)) * 2; }
__device__ __forceinline__ int v_rd_base(int lane) { return ((lane & 3) << 3) | (((lane >> 2) & 3) << 6) | (((lane >> 4) & 1) << 5) | (((lane >> 5) & 1) << 8); }
constexpr int v_rd_off(int d0, int ks, int half) { return d0 * 512 + ks * 4096 + half * 2048; }
template <int OFF> __device__ __forceinline__ s16x4 tr_read(int vb) { s16x4 r; asm volatile("ds_read_b64_tr_b16 %0, %1 offset:%2" : "=&v"(r) : "v"(vb), "i"(OFF) : "memory"); return r; }
struct VFrag { s16x4 l0, h0, l1, h1, l2, h2, l3, h3; };
template <int D0> __device__ __forceinline__ void pv_read(VFrag& f, int vb) {
  f.l0 = tr_read<v_rd_off(D0, 0, 0)>(vb); f.h0 = tr_read<v_rd_off(D0, 0, 1)>(vb); f.l1 = tr_read<v_rd_off(D0, 1, 0)>(vb); f.h1 = tr_read<v_rd_off(D0, 1, 1)>(vb);
  f.l2 = tr_read<v_rd_off(D0, 2, 0)>(vb); f.h2 = tr_read<v_rd_off(D0, 2, 1)>(vb); f.l3 = tr_read<v_rd_off(D0, 3, 0)>(vb); f.h3 = tr_read<v_rd_off(D0, 3, 1)>(vb);
}
__device__ __forceinline__ void pv_mma(f32x16& od, const VFrag& f, bf16x8 pa0, bf16x8 pa1, bf16x8 pa2, bf16x8 pa3) {
#define PKV(L, H) (bf16x8){L[0], L[1], L[2], L[3], H[0], H[1], H[2], H[3]}
  od = __builtin_amdgcn_mfma_f32_32x32x16_bf16(pa0, PKV(f.l0, f.h0), od, 0, 0, 0);
  od = __builtin_amdgcn_mfma_f32_32x32x16_bf16(pa1, PKV(f.l1, f.h1), od, 0, 0, 0);
  od = __builtin_amdgcn_mfma_f32_32x32x16_bf16(pa2, PKV(f.l2, f.h2), od, 0, 0, 0);
  od = __builtin_amdgcn_mfma_f32_32x32x16_bf16(pa3, PKV(f.l3, f.h3), od, 0, 0, 0);
#undef PKV
}
__device__ __forceinline__ void pv_d0(f32x16* o, int vb, bf16x8 pa0, bf16x8 pa1, bf16x8 pa2, bf16x8 pa3) {
  VFrag fa, fb;
  pv_read<0>(fa, vb);
  pv_read<1>(fb, vb); asm volatile("s_waitcnt lgkmcnt(8)" ::: "memory"); SBAR();
  pv_mma(o[0], fa, pa0, pa1, pa2, pa3); SBAR();
  pv_read<2>(fa, vb); asm volatile("s_waitcnt lgkmcnt(8)" ::: "memory"); SBAR();
  pv_mma(o[1], fb, pa0, pa1, pa2, pa3); SBAR();
  pv_read<3>(fb, vb); asm volatile("s_waitcnt lgkmcnt(8)" ::: "memory"); SBAR();
  pv_mma(o[2], fa, pa0, pa1, pa2, pa3); SBAR();
  asm volatile("s_waitcnt lgkmcnt(0)" ::: "memory"); SBAR();
  pv_mma(o[3], fb, pa0, pa1, pa2, pa3);
}

__device__ __forceinline__ void attn_item(const bf16_t* Qb, const bf16_t* Kh, const bf16_t* Vh, bf16_t* Ob, int seq, char* lds, float lam, const float* gain) {
  int tid_ = threadIdx.x; asm volatile("" : "+v"(tid_));
  const int tid = tid_, wid = __builtin_amdgcn_readfirstlane(tid >> 6), lane = tid & 63, r32 = lane & 31, hi = lane >> 5, qg = wid >> 1, z = wid & 1;
  char* V_lds = lds; char* K_lds = lds + 3 * SHM_V;
  float* wsf = (float*)(lds + 3 * SHM_V + 2 * SHM_K) + wid * 128; float* al_l = wsf; float* li = wsf + 32;
  float m = 0.f, l = 0.f; f32x16 o[4]; bf16x8 qr[4]; f32x16 negv;
#pragma unroll
  for (int r = 0; r < 16; ++r) negv[r] = 0.f;
#pragma unroll
  for (int d = 0; d < 4; ++d)
#pragma unroll
    for (int r = 0; r < 16; ++r) o[d][r] = 0.f;
  const bf16_t* Qw = Qb + (size_t)(qg * 32 + r32) * 128 + z * 64 + hi * 8;
#pragma unroll
  for (int d0 = 0; d0 < 4; ++d0) qr[d0] = *(const bf16x8*)(Qw + d0 * 16);
  const int sr = tid >> 4, sc = (tid & 15) * 8;
  const int vb0 = (int)(uintptr_t)V_lds + v_rd_base(lane);
  bf16x8 sv[2], sk[2];
#define LOADKV(SK, SV, k0) do { _Pragma("unroll") for (int i = 0; i < 2; ++i) { SK[i] = *(const bf16x8*)(Kh + (size_t)((k0) + sr + 32 * i) * 128 + sc); SV[i] = *(const bf16x8*)(Vh + (size_t)((k0) + sr + 32 * i) * 128 + sc); } } while (0)
#define WRITEKV(SK, SV, kb, vb) do { _Pragma("unroll") for (int i = 0; i < 2; ++i) { *(bf16x8*)(K_lds + (kb) * SHM_K + KSWZ(sr + 32 * i, sc * 2)) = SK[i]; *(bf16x8*)(V_lds + (vb) * SHM_V + v_st(sr + 32 * i, sc)) = SV[i]; } } while (0)
  const int NT = seq >> 6;
  const bool late = wid >= 4;
  bf16x8 pa0, pa1, pa2, pa3;
  bf16x8 skB[2], svB[2];
#define ATT_INTERVAL(j, kb, vcur, vprev) do { \
    if (late && (j) > 0) { pv_d0(o, vb0 + (vprev) * SHM_V, pa0, pa1, pa2, pa3); SBAR(); } \
    { f32x16 p0, p1; float al; \
      qkt(p0, p1, K_lds + (kb) * SHM_K, qr, r32, hi, z, negv); \
      partialSM(p0, p1, m, al, negv, (j) == 0); \
      SBAR(); \
      if (__any(al < 1.f)) { if (hi == 0) al_l[r32] = al; asm volatile("s_waitcnt lgkmcnt(0)" ::: "memory"); \
        _Pragma("unroll") for (int r = 0; r < 16; ++r) { const float f = al_l[crow(r, hi)]; _Pragma("unroll") for (int d = 0; d < 4; ++d) o[d][r] *= f; } } \
      finishSM(p0, p1, al, l, pa0, pa1, pa2, pa3); SBAR(); } \
    if (!late) { pv_d0(o, vb0 + (vcur) * SHM_V, pa0, pa1, pa2, pa3); SBAR(); } } while (0)
  __syncthreads();
  LOADKV(sk, sv, 0); WRITEKV(sk, sv, 0, 0);
  LOADKV(sk, sv, 64); LOADKV(skB, svB, 128);
  __syncthreads();
  int vcur = 0;
  for (int j = 0; j < NT; j += 2) {
    { const int vnext = vcur == 2 ? 0 : vcur + 1, vprev = vcur == 0 ? 2 : vcur - 1;
      SBAR();
      ATT_INTERVAL(j, 0, vcur, vprev);
      WRITEKV(sk, sv, 1, vnext);
      if (j + 3 < NT) LOADKV(sk, sv, (j + 3) * 64);
      __syncthreads();
      vcur = vnext; }
    { const int vnext = vcur == 2 ? 0 : vcur + 1, vprev = vcur == 0 ? 2 : vcur - 1;
      SBAR();
      ATT_INTERVAL(j + 1, 1, vcur, vprev);
      if (j + 2 < NT) { WRITEKV(skB, svB, 0, vnext); if (j + 4 < NT) LOADKV(skB, svB, (j + 4) * 64); }
      __syncthreads();
      vcur = vnext; }
  }
#undef ATT_INTERVAL
  if (late) { const int vlast = vcur == 0 ? 2 : vcur - 1; pv_d0(o, vb0 + vlast * SHM_V, pa0, pa1, pa2, pa3); }
  __syncthreads();
  if (hi == 0) li[r32] = l;
  asm volatile("s_waitcnt lgkmcnt(0)" ::: "memory");
  float* xch = (float*)lds + qg * 4096;
  if (z == 1) {
#pragma unroll
    for (int r = 0; r < 16; ++r) { const int rr = crow(r, hi); const float f = lam / li[rr];
#pragma unroll
      for (int d = 0; d < 4; ++d) xch[rr * 128 + d * 32 + r32] = o[d][r] * f; }
  }
  __syncthreads();
  if (z == 0) {
    float g4v[4];
#pragma unroll
    for (int d = 0; d < 4; ++d) g4v[d] = gain[d * 32 + r32] * 0.8f;
#pragma unroll
    for (int r = 0; r < 16; ++r) { const int rr = crow(r, hi); const float i0 = 1.f / li[rr]; float q = 0.f;
#pragma unroll
      for (int d = 0; d < 4; ++d) { const float v = o[d][r] * i0 - xch[rr * 128 + d * 32 + r32]; o[d][r] = v; q += v * v; }
#pragma unroll
      for (int mm = 1; mm < 32; mm <<= 1) q += __shfl_xor(q, mm);
      const float rs = rsqrtf(q * (1.f / 128.f) + EPS);
      bf16_t* orow = Ob + (size_t)(qg * 32 + rr) * 128 + r32;
#pragma unroll
      for (int d = 0; d < 4; ++d) orow[d * 32] = f2bf(o[d][r] * rs * g4v[d]); }
  }
#undef LOADKV
#undef WRITEKV
}

constexpr int XQ_GP = 1, XQ_AP = 128, XQ_GS = 8, XQ_AS = 256, XQ_ITEMS = XQ_GP + XQ_AP + XQ_GS + XQ_AS;
__device__ __forceinline__ unsigned xcc_id() { return (unsigned)__builtin_amdgcn_s_getreg((3 << 11) | 20) & 0xFu; }
__device__ NOINL void phase2(const Params& p) {
  char* lds = g_lds;
  unsigned* qctr = (unsigned*)(p.ws + OFF_MISC) + 64;
  const float lam = ((const float*)(p.ws + OFF_MISC))[0];
  int* slot = (int*)(lds + LDS_BYTES - 64);
  const int x0 = (int)(xcc_id() & 7u);
  for (int xi = 0; xi < 8; ++xi) {
    const int x = (x0 + xi) & 7;
    for (;;) {
      __syncthreads();
      if (threadIdx.x == 0) *slot = (int)atomicAdd(qctr + x * 32, 1u);
      __syncthreads();
      int it = *slot;
      if (it >= XQ_ITEMS) break;
      bool is_gla; int s, a1, a2;
      if (it < XQ_GP) { const int g = x * XQ_GP + it; is_gla = true; s = 0; a1 = g >> 1; a2 = g & 1; }
      else if ((it -= XQ_GP) < XQ_AP) { is_gla = false; s = 0; a1 = x; a2 = it; }
      else if ((it -= XQ_AP) < XQ_GS) { const int g = x * XQ_GS + it; is_gla = true; s = 1 + (g >> 3); const int r = g & 7; a1 = r >> 1; a2 = r & 1; }
      else { it -= XQ_GS; is_gla = false; s = 1 + (it >> 5); a1 = x; a2 = it & 31; }
      if (is_gla) gla_item(p, s, a1, a2, lds);
      else { const size_t sb = ((size_t)a1 * NTOK + seq_base(s)) * 128, qo = sb + (size_t)(a2 * 128) * 128;
        attn_item((const bf16_t*)(p.ws + OFF_DQ) + qo, (const bf16_t*)(p.ws + OFF_DK) + sb, (const bf16_t*)(p.ws + OFF_DV) + sb, (bf16_t*)(p.ws + OFF_DQ) + qo, seq_len(s), lds, lam, p.diff_norm_gain); }
    }
  }
}

__device__ NOINL void phase3a(const Params& p) {
  char* lds = g_lds;
  int tid_ = threadIdx.x; asm volatile("" : "+v"(tid_));
  const int tid = tid_, lane = tid & 63, wid = tid >> 6, wm = wid >> 1, wn = wid & 1, c32 = lane & 31, hi = lane >> 5;
  const bf16_t* H = (const bf16_t*)(p.ws + OFF_H3); const bf16_t* W = (const bf16_t*)(p.ws + OFF_WP3);
  constexpr int NT = 16;
  for (int rr = 0;; ++rr) {
    int mt, nt; if (!patch_tile(rr, NT, mt, nt)) break;
    const int m0 = mt * 256, n0 = nt * 128;
    f32x16 acc[2][2]; zero_acc(acc);
    gemm_tile<true>(H + (size_t)m0 * DM, DM, W + (size_t)n0 * DM, DM, DM, lds, acc);
    const int rw = m0 + wm * 64, cw = (n0 & 1023) + wn * 64, seg = nt >> 3;
    const bf16_t* src = (const bf16_t*)(p.ws + (seg == 0 ? OFF_OGN : OFF_DQ));
    bf16_t* dst = seg == 0 ? (bf16_t*)(p.ws + OFF_A2) : seg == 1 ? (bf16_t*)(p.ws + OFF_A3) : seg == 2 ? (bf16_t*)p.out : (bf16_t*)p.out + (size_t)NTOK * DM;
#pragma unroll
    for (int mi = 0; mi < 2; ++mi)
#pragma unroll
      for (int ni = 0; ni < 2; ++ni)
#pragma unroll
        for (int g = 0; g < 4; ++g) {
          if (seg < 2) { const int tok = rw + mi * 32 + c32, col = cw + ni * 32 + 8 * g + 4 * hi;
            const u32x2 sv = *(const u32x2*)(src + (seg == 0 ? (size_t)tok * DM + col : ((size_t)(col >> 7) * NTOK + tok) * 128 + (col & 127)));
            acc[mi][ni][4 * g] = bflo(sv.x) * siluf(acc[mi][ni][4 * g]); acc[mi][ni][4 * g + 1] = bfhi(sv.x) * siluf(acc[mi][ni][4 * g + 1]);
            acc[mi][ni][4 * g + 2] = bflo(sv.y) * siluf(acc[mi][ni][4 * g + 2]); acc[mi][ni][4 * g + 3] = bfhi(sv.y) * siluf(acc[mi][ni][4 * g + 3]); }
          else {
#pragma unroll
            for (int e = 0; e < 4; ++e) acc[mi][ni][4 * g + e] = sigmf(acc[mi][ni][4 * g + e]); } }
    store_rows_bf16(acc, dst, DM, rw, cw, c32, hi);
  }
}
__device__ NOINL void phase3bc(const Params& p) {
  char* lds = g_lds;
  int tid_ = threadIdx.x; asm volatile("" : "+v"(tid_));
  const int tid = tid_, lane = tid & 63, wid = tid >> 6, wm = wid >> 1, wn = wid & 1, c32 = lane & 31, hi = lane >> 5;
  const bf16_t* A2 = (const bf16_t*)(p.ws + OFF_A2); const bf16_t* A3 = (const bf16_t*)(p.ws + OFF_A3);
  const bf16_t* SG = (const bf16_t*)p.out; const bf16_t* SD = SG + (size_t)NTOK * DM; bf16_t* MR = (bf16_t*)(p.ws + OFF_MRG);
  for (int rr = 0;; ++rr) {
    int mt, nt; if (!patch_tile(rr, 8, mt, nt)) break;
    const int m0 = mt * 256, n0 = nt * 128;
    const bf16_t* H3 = (const bf16_t*)(p.ws + OFF_H3) + (size_t)m0 * DM; const bf16_t* WM = (const bf16_t*)(p.ws + OFF_WP3) + (size_t)(2048 + n0) * DM;
    const int rw = m0 + wm * 64, cw = n0 + wn * 64;
    f32x16 a1[2][2]; unsigned tg[2][2][8], sd[2][2][8];
    zero_acc(a1); gemm_tile<true>(H3, DM, WM, DM, DM, lds, a1);
#pragma unroll
    for (int mi = 0; mi < 2; ++mi)
#pragma unroll
      for (int ni = 0; ni < 2; ++ni)
#pragma unroll
        for (int q = 0; q < 8; ++q) tg[mi][ni][q] = cvtpk(sigmf(a1[mi][ni][2 * q]), sigmf(a1[mi][ni][2 * q + 1]));
    zero_acc(a1); gemm_tile<true>(A2 + (size_t)m0 * DM, DM, (const bf16_t*)(p.ws + OFF_WG) + (size_t)n0 * DM, DM, DM, lds, a1);
#pragma unroll
    for (int mi = 0; mi < 2; ++mi)
#pragma unroll
      for (int ni = 0; ni < 2; ++ni)
#pragma unroll
        for (int q = 0; q < 8; ++q) tg[mi][ni][q] = cvtpk(bflo(tg[mi][ni][q]) * a1[mi][ni][2 * q], bfhi(tg[mi][ni][q]) * a1[mi][ni][2 * q + 1]);
    zero_acc(a1); gemm_tile<true>(H3, DM, WM + (size_t)1024 * DM, DM, DM, lds, a1);
#pragma unroll
    for (int mi = 0; mi < 2; ++mi)
#pragma unroll
      for (int ni = 0; ni < 2; ++ni)
#pragma unroll
        for (int q = 0; q < 8; ++q) sd[mi][ni][q] = cvtpk(sigmf(a1[mi][ni][2 * q]), sigmf(a1[mi][ni][2 * q + 1]));
    zero_acc(a1); gemm_tile<true>(A3 + (size_t)m0 * DM, DM, (const bf16_t*)(p.ws + OFF_WD) + (size_t)n0 * DM, DM, DM, lds, a1);
#pragma unroll
    for (int mi = 0; mi < 2; ++mi)
#pragma unroll
      for (int ni = 0; ni < 2; ++ni)
#pragma unroll
        for (int q = 0; q < 8; ++q) { a1[mi][ni][2 * q] = bflo(tg[mi][ni][q]) + bflo(sd[mi][ni][q]) * a1[mi][ni][2 * q]; a1[mi][ni][2 * q + 1] = bfhi(tg[mi][ni][q]) + bfhi(sd[mi][ni][q]) * a1[mi][ni][2 * q + 1]; }
    store_rows_bf16(a1, MR, DM, rw, cw, c32, hi);
  }
}
__device__ NOINL void phase3d(const Params& p) {
  char* lds = g_lds;
  int tid_ = threadIdx.x; asm volatile("" : "+v"(tid_));
  const int tid = tid_, lane = tid & 63, wid = tid >> 6, wm = wid >> 1, wn = wid & 1, c32 = lane & 31, hi = lane >> 5;
  const bf16_t* MR = (const bf16_t*)(p.ws + OFF_MRG); const float* mod = (const float*)(p.ws + OFF_MOD);
  for (int rr = 0;; ++rr) {
    int mt, nt; if (!patch_tile(rr, 8, mt, nt)) break;
    const int m0 = mt * 256, n0 = nt * 128;
    f32x16 acc[2][2]; zero_acc(acc);
    gemm_tile<true>(MR + (size_t)m0 * DM, DM, (const bf16_t*)(p.ws + OFF_WO) + (size_t)n0 * DM, DM, DM, lds, acc);
    const int rw = m0 + wm * 64, cw = n0 + wn * 64, s = seq_of_row(m0);
#pragma unroll
    for (int ni = 0; ni < 2; ++ni)
#pragma unroll
      for (int g = 0; g < 4; ++g) { const int col = cw + ni * 32 + 8 * g + 4 * hi; const f32x4 gt = *(const f32x4*)(mod + s * 3072 + 2048 + col);
#pragma unroll
        for (int mi = 0; mi < 2; ++mi) { const int row = rw + mi * 32 + c32; const f32x4 xv = *(const f32x4*)(xrow(p, row) + col);
          const f32x4 av = {acc[mi][ni][4 * g], acc[mi][ni][4 * g + 1], acc[mi][ni][4 * g + 2], acc[mi][ni][4 * g + 3]};
          *(f32x4*)(p.out + (size_t)row * DM + col) = xv + gt * av; } }
  }
}
__device__ NOINL void phase3e(const Params& p) {
  const int lane = threadIdx.x & 63, wid = threadIdx.x >> 6;
  f32x4 fg[4];
#pragma unroll
  for (int i = 0; i < 4; ++i) fg[i] = *(const f32x4*)(p.final_gain + i * 256 + lane * 4);
  for (int row = blockIdx.x * 8 + wid; row < NTOK; row += gridDim.x * 8) {
    float* o = p.out + (size_t)row * DM; f32x4 v[4]; float ss = 0.f;
#pragma unroll
    for (int i = 0; i < 4; ++i) { v[i] = *(const f32x4*)(o + i * 256 + lane * 4); ss += v[i][0] * v[i][0] + v[i][1] * v[i][1] + v[i][2] * v[i][2] + v[i][3] * v[i][3]; }
#pragma unroll
    for (int m = 1; m < 64; m <<= 1) ss += __shfl_xor(ss, m);
    const float rstd = rsqrtf(ss * (1.f / 1024.f) + EPS);
#pragma unroll
    for (int i = 0; i < 4; ++i) *(f32x4*)(o + i * 256 + lane * 4) = v[i] * rstd * fg[i];
  }
}

constexpr int NPHASE = 9;
__device__ __forceinline__ void gbar(unsigned* ctr, unsigned& epoch) {
  __syncthreads();
  if (threadIdx.x == 0) {
    epoch += gridDim.x;
    __builtin_amdgcn_fence(__ATOMIC_RELEASE, "agent");
    __hip_atomic_fetch_add(ctr, 1u, __ATOMIC_RELAXED, __HIP_MEMORY_SCOPE_AGENT);
    while (__hip_atomic_load(ctr, __ATOMIC_RELAXED, __HIP_MEMORY_SCOPE_AGENT) < epoch) __builtin_amdgcn_s_sleep(1);
    __builtin_amdgcn_fence(__ATOMIC_ACQUIRE, "agent");
  }
  __syncthreads();
}
template <int PB, int PE>
__global__ void __launch_bounds__(NTHR) mega(Params p) {
  char* lds = g_lds;
  unsigned epoch = 0; unsigned* bctr = (unsigned*)(p.ws + OFF_MISC) + 512;
#define PHASE(i, call) if constexpr (PB <= i && i < PE) { call; if constexpr (i + 1 < PE) { if constexpr (i == 0) cg::this_grid().sync(); else gbar(bctr, epoch); } }
  PHASE(0, phase0(p))
  PHASE(1, phase_h<false>(p, (bf16_t*)((char*)p.out + SZ_FULL)))
  PHASE(2, phase1(p))
  PHASE(3, phase2(p))
  PHASE(4, phase_h<true>(p, (bf16_t*)(p.ws + OFF_H3)))
  PHASE(5, phase3a(p))
  PHASE(6, phase3bc(p))
  PHASE(7, phase3d(p))
  PHASE(8, phase3e(p))
#undef PHASE
  (void)lds;
}

extern "C" void kernel_launch(void* const* d_in, const int* in_sizes, int n_in, void* d_out, int out_size, void* d_ws, size_t ws_size, hipStream_t stream) {
  if (n_in != 18 || out_size != NTOK * DM || ws_size < WS_NEED) { fprintf(stderr, "kernel_launch: unexpected shapes (n_in %d out %d ws %zu need %zu)\n", n_in, out_size, ws_size, WS_NEED); return; }
  Params p{};
  p.x_prompt = (const float*)d_in[0]; p.x_sample = (const float*)d_in[1]; p.c_prompt = (const float*)d_in[2]; p.c_sample = (const float*)d_in[3];
  p.w_ada = (const float*)d_in[4]; p.b_ada = (const float*)d_in[5]; p.norm_gain = (const float*)d_in[6]; p.w_in = (const float*)d_in[7];
  p.w_alpha = (const float*)d_in[8]; p.b_alpha = (const float*)d_in[9]; p.gla_norm_gain = (const float*)d_in[10]; p.lambda_q = (const float*)d_in[11];
  p.lambda_k = (const float*)d_in[12]; p.diff_norm_gain = (const float*)d_in[13]; p.w_bo_gla = (const float*)d_in[14]; p.w_bo_diff = (const float*)d_in[15];
  p.w_out = (const float*)d_in[16]; p.final_gain = (const float*)d_in[17]; p.out = (float*)d_out; p.ws = (char*)d_ws;
  static int grid_blocks = 0;
  if (!grid_blocks) { int dev = 0, cus = 0, per_cu = 0; hipGetDevice(&dev); hipDeviceGetAttribute(&cus, hipDeviceAttributeMultiprocessorCount, dev);
    hipOccupancyMaxActiveBlocksPerMultiprocessor(&per_cu, mega<0, NPHASE>, NTHR, 0); if (per_cu < 1) per_cu = 1; grid_blocks = cus * per_cu; }
#if COOP
  void* args[] = {&p};
  hipError_t e = hipLaunchCooperativeKernel((void*)mega<0, NPHASE>, dim3(grid_blocks), dim3(NTHR), args, 0, stream);
  if (e != hipSuccess) fprintf(stderr, "cooperative launch failed: %s (grid %d)\n", hipGetErrorString(e), grid_blocks);
#else
  hipLaunchKernelGGL((mega<0, 1>), dim3(grid_blocks), dim3(NTHR), 0, stream, p);
  hipLaunchKernelGGL((mega<1, 2>), dim3(grid_blocks), dim3(NTHR), 0, stream, p);
  hipLaunchKernelGGL((mega<2, 3>), dim3(grid_blocks), dim3(NTHR), 0, stream, p);
  hipLaunchKernelGGL((mega<3, 4>), dim3(grid_blocks), dim3(NTHR), 0, stream, p);
  hipLaunchKernelGGL((mega<4, 5>), dim3(grid_blocks), dim3(NTHR), 0, stream, p);
  hipLaunchKernelGGL((mega<5, 6>), dim3(grid_blocks), dim3(NTHR), 0, stream, p);
  hipLaunchKernelGGL((mega<6, 7>), dim3(grid_blocks), dim3(NTHR), 0, stream, p);
  hipLaunchKernelGGL((mega<7, 8>), dim3(grid_blocks), dim3(NTHR), 0, stream, p);
  hipLaunchKernelGGL((mega<8, 9>), dim3(grid_blocks), dim3(NTHR), 0, stream, p);
#endif
}
```

```cpp
#include <hip/hip_runtime.h>
#include <hip/hip_cooperative_groups.h>
#include <cstdio>
#include <cstdint>
namespace cg = cooperative_groups;

#ifndef COOP
#define COOP 1
#endif

typedef unsigned short bf16_t;
using bf16x8 = __attribute__((ext_vector_type(8))) short;
using s16x4  = __attribute__((ext_vector_type(4))) short;
using f32x16 = __attribute__((ext_vector_type(16))) float;
using f32x4  = __attribute__((ext_vector_type(4))) float;
using f32x2  = __attribute__((ext_vector_type(2))) float;
using u32x4  = __attribute__((ext_vector_type(4))) unsigned;
using u32x2  = __attribute__((ext_vector_type(2))) unsigned;

constexpr int DM = 1024, LP = 16384, LS = 4096, NSEQ = 9, NTOK = LP + 8 * LS;
constexpr int INC = 9248;
constexpr int NP1 = 5248;
constexpr int NP3 = 4096;
constexpr float EPS = 1e-6f;

constexpr size_t SZ_HALF = (size_t)NTOK * 512 * 2;
constexpr size_t SZ_FULL = (size_t)NTOK * 1024 * 2;
constexpr size_t OFF_GQ = 0, OFF_GK = OFF_GQ + SZ_HALF, OFF_GV = OFF_GK + SZ_HALF, OFF_DQ = OFF_GV + SZ_FULL, OFF_DK = OFF_DQ + SZ_FULL, OFF_DV = OFF_DK + SZ_FULL;
constexpr size_t OFF_LOW = OFF_DV + SZ_FULL, SZ_LOW = (size_t)NTOK * 32 * 4;
constexpr size_t OFF_WP1 = OFF_LOW + SZ_LOW, OFF_WP3 = OFF_WP1 + (size_t)NP1 * 1024 * 2, OFF_WG = OFF_WP3 + (size_t)NP3 * 1024 * 2;
constexpr size_t OFF_WD = OFF_WG + 2097152, OFF_WO = OFF_WD + 2097152, OFF_MOD = OFF_WO + 2097152;
constexpr size_t OFF_ROPE = OFF_MOD + (size_t)NSEQ * 3072 * 4, OFF_MISC = OFF_ROPE + 65536, WS_NEED = OFF_MISC + 4096;
constexpr size_t OFF_H3 = OFF_GQ, OFF_OGN = OFF_GV, OFF_A2 = OFF_DK, OFF_A3 = OFF_DV, OFF_MRG = OFF_GV;

constexpr int LDS_BYTES = 152 * 1024, NTHR = 512;
__shared__ __attribute__((aligned(16))) char g_lds[LDS_BYTES];
#define NOINL __forceinline__

struct Params {
  const float *x_prompt, *x_sample, *c_prompt, *c_sample, *w_ada, *b_ada, *norm_gain, *w_in, *w_alpha, *b_alpha, *gla_norm_gain, *lambda_q, *lambda_k,
      *diff_norm_gain, *w_bo_gla, *w_bo_diff, *w_out, *final_gain;
  float* out; char* ws;
};

typedef __bf16 bf16n2 __attribute__((ext_vector_type(2)));
__device__ __forceinline__ unsigned cvtpk(float lo, float hi) { const f32x2 v = {lo, hi}; const bf16n2 b = __builtin_convertvector(v, bf16n2); return __builtin_bit_cast(unsigned, b); }
__device__ __forceinline__ bf16_t f2bf(float x) { return (bf16_t)(cvtpk(x, 0.f) & 0xffffu); }
__device__ __forceinline__ float bf2f(bf16_t v) { return __uint_as_float((unsigned)v << 16); }
__device__ __forceinline__ float bflo(unsigned w) { return __uint_as_float(w << 16); }
__device__ __forceinline__ float bfhi(unsigned w) { return __uint_as_float(w & 0xffff0000u); }
__device__ __forceinline__ int crow(int r, int hi) { return (r & 3) + 8 * (r >> 2) + 4 * hi; }
__device__ __forceinline__ float siluf(float x) { return x * __builtin_amdgcn_rcpf(1.f + __expf(-x)); }
__device__ __forceinline__ float sigmf(float x) { return __builtin_amdgcn_rcpf(1.f + __expf(-x)); }
__device__ __forceinline__ int seq_of_row(int row) { return row < LP ? 0 : 1 + ((row - LP) >> 12); }
__device__ __forceinline__ int seq_base(int s) { return s == 0 ? 0 : LP + (s - 1) * LS; }
__device__ __forceinline__ int seq_len(int s) { return s == 0 ? LP : LS; }
__device__ __forceinline__ const float* xrow(const Params& p, int row) { return row < LP ? p.x_prompt + (size_t)row * DM : p.x_sample + (size_t)(row - LP) * DM; }

__device__ void sincos_d(double a, double& s, double& c) {
  const double n = rint(a * 0.63661977236758134308);
  double y = a - n * 1.5707963267341256; y -= n * 6.077100506506192e-11;
  const double y2 = y * y;
  double sp = 1.0 / 355687428096000.0;
  sp = sp * y2 - 1.0 / 1307674368000.0; sp = sp * y2 + 1.0 / 6227020800.0; sp = sp * y2 - 1.0 / 39916800.0; sp = sp * y2 + 1.0 / 362880.0;
  sp = sp * y2 - 1.0 / 5040.0; sp = sp * y2 + 1.0 / 120.0; sp = sp * y2 - 1.0 / 6.0; sp = sp * y2 + 1.0; sp *= y;
  double cp = 1.0 / 20922789888000.0;
  cp = cp * y2 - 1.0 / 87178291200.0; cp = cp * y2 + 1.0 / 479001600.0; cp = cp * y2 - 1.0 / 3628800.0; cp = cp * y2 + 1.0 / 40320.0;
  cp = cp * y2 - 1.0 / 720.0; cp = cp * y2 + 1.0 / 24.0; cp = cp * y2 - 0.5; cp = cp * y2 + 1.0;
  const int q = ((int)n) & 3;
  s = (q == 0) ? sp : (q == 1) ? cp : (q == 2) ? -sp : -cp;
  c = (q == 0) ? cp : (q == 1) ? -sp : (q == 2) ? -cp : sp;
}

constexpr int P0_MOD_TASKS = 192;
constexpr int T_WP1 = NP1 / 64  , T_WP3 = NP3 / 64  , T_SQ = 16;
constexpr int P0_TR_TILES = (T_WP1 + T_WP3 + 3 * T_SQ) * 16;
constexpr int P0_TASKS = P0_MOD_TASKS + P0_TR_TILES + 1 + 16;

__device__ void p0_mod_task(const Params& p, int t, char* lds) {
  float* sc = (float*)lds;
  float* red = (float*)(lds + 36864);
  const int tid = threadIdx.x;
  for (int i = tid; i < NSEQ * 1024; i += NTHR) { const int s = i >> 10, k = i & 1023; const float c = s == 0 ? p.c_prompt[k] : p.c_sample[(s - 1) * 1024 + k]; sc[i] = siluf(c); }
  __syncthreads();
  const int col = tid & 15, kp = tid >> 4, n = t * 16 + col;
  float acc[NSEQ];
#pragma unroll
  for (int s = 0; s < NSEQ; ++s) acc[s] = 0.f;
  for (int kk = 0; kk < 32; ++kk) { const int k = kp * 32 + kk; const float w = p.w_ada[(size_t)k * 3072 + n];
#pragma unroll
    for (int s = 0; s < NSEQ; ++s) acc[s] += sc[s * 1024 + k] * w; }
#pragma unroll
  for (int s = 0; s < NSEQ; ++s) red[(kp * NSEQ + s) * 16 + col] = acc[s];
  __syncthreads();
  if (tid < NSEQ * 16) { const int s = tid >> 4, c2 = tid & 15; float a = p.b_ada[t * 16 + c2];
    for (int q = 0; q < 32; ++q) a += red[(q * NSEQ + s) * 16 + c2];
    ((float*)(p.ws + OFF_MOD))[s * 3072 + t * 16 + c2] = a; }
  __syncthreads();
}

__device__ void p0_tr_tile(const float* src, int ld, int c0, int nvalid, bf16_t* dst, int n0, int k0, char* lds) {
  bf16_t* tile = (bf16_t*)lds;
  const int tid = threadIdx.x, kr = tid >> 4, c4 = (tid & 15) * 4;
#pragma unroll
  for (int i = 0; i < 2; ++i) { const int k = kr + 32 * i; f32x4 v = {0.f, 0.f, 0.f, 0.f};
    if (c4 < nvalid) v = *(const f32x4*)(src + (size_t)(k0 + k) * ld + c0 + c4);
    tile[(c4 + 0) * 72 + k] = f2bf(v[0]); tile[(c4 + 1) * 72 + k] = f2bf(v[1]); tile[(c4 + 2) * 72 + k] = f2bf(v[2]); tile[(c4 + 3) * 72 + k] = f2bf(v[3]); }
  __syncthreads();
  { const int n = tid >> 3, kq = (tid & 7) * 8;
    const u32x4 a = *(const u32x4*)(tile + n * 72 + kq);
    bf16_t* d = dst + (size_t)(n0 + n) * 1024 + k0 + kq; *(u32x4*)d = a; }
  __syncthreads();
}

__device__ NOINL void phase0(const Params& p) {
  char* lds = g_lds;
  for (int t = blockIdx.x; t < P0_TASKS; t += gridDim.x) {
    if (t < P0_MOD_TASKS) { p0_mod_task(p, t, lds); continue; }
    int u = t - P0_MOD_TASKS;
    if (u < P0_TR_TILES) {
      const int kt = u & 15; int ct = u >> 4;
      if (ct < T_WP1) { const int n0 = ct * 64; int c0, nv = 64;
        if (n0 < 2048) c0 = n0; else if (n0 < 5120) c0 = 3104 + (n0 - 2048); else if (n0 < 5184) { c0 = 3072; nv = 32; } else { c0 = 0; nv = 0; }
        p0_tr_tile(p.w_in, INC, c0, nv, (bf16_t*)(p.ws + OFF_WP1), n0, kt * 64, lds); continue; }
      ct -= T_WP1;
      if (ct < T_WP3) { const int n0 = ct * 64; const int c0 = n0 < 1024 ? 2048 + n0 : n0 < 2048 ? 6176 + (n0 - 1024) : 7200 + (n0 - 2048);
        p0_tr_tile(p.w_in, INC, c0, 64, (bf16_t*)(p.ws + OFF_WP3), n0, kt * 64, lds); continue; }
      ct -= T_WP3;
      const int which = ct >> 4, n0 = (ct & 15) * 64;
      const float* src = which == 0 ? p.w_bo_gla : which == 1 ? p.w_bo_diff : p.w_out;
      bf16_t* dst = (bf16_t*)(p.ws + (which == 0 ? OFF_WG : which == 1 ? OFF_WD : OFF_WO));
      p0_tr_tile(src, 1024, n0, 64, dst, n0, kt * 64, lds); continue;
    }
    u -= P0_TR_TILES;
    if (u == 0) {
      if (threadIdx.x == 0) { float a = 0.f, b = 0.f; for (int i = 0; i < 64; ++i) { a += p.lambda_q[i] * p.lambda_k[i]; b += p.lambda_q[64 + i] * p.lambda_k[64 + i]; }
        float* misc = (float*)(p.ws + OFF_MISC); misc[0] = expf(a) - expf(b) + 0.2f; for (int q = 0; q < 8; ++q) ((unsigned*)misc)[64 + q * 32] = 0u; ((unsigned*)misc)[512] = 0u; }
      continue; }
    u -= 1;
    { const int idx = u * NTHR + threadIdx.x, tab = idx >> 12, a = (idx >> 5) & 127, i = idx & 31;
      double inv = 1.0; for (int q = 0; q < i; ++q) inv *= 0.7498942093324558;
      const double ang = (tab == 0 ? 128.0 * (double)a : (double)a) * inv; double s, c; sincos_d(ang, s, c);
      ((f32x2*)(p.ws + OFF_ROPE))[idx] = (f32x2){(float)c, (float)s}; }
  }
}

template <bool WITH_OGN>
__device__ NOINL void phase_h(const Params& p, bf16_t* hdst) {
  const int lane = threadIdx.x & 63, wid = threadIdx.x >> 6;
  const float* mod = (const float*)(p.ws + OFF_MOD);
  int scur = -1; f32x4 ca[4], cb[4];
  f32x4 gg0 = {0.f, 0.f, 0.f, 0.f}, gg1 = gg0;
  if constexpr (WITH_OGN) { gg0 = *(const f32x4*)(p.gla_norm_gain + ((lane * 8) & 255)); gg1 = *(const f32x4*)(p.gla_norm_gain + ((lane * 8) & 255) + 4); }
  for (int row = blockIdx.x * 8 + wid; row < NTOK; row += gridDim.x * 8) {
    const float* x = xrow(p, row); const int s = seq_of_row(row);
    f32x4 v[4]; float ss = 0.f;
#pragma unroll
    for (int i = 0; i < 4; ++i) { v[i] = __builtin_nontemporal_load((const f32x4*)(x + i * 256 + lane * 4)); ss += v[i][0] * v[i][0] + v[i][1] * v[i][1] + v[i][2] * v[i][2] + v[i][3] * v[i][3]; }
#pragma unroll
    for (int m = 1; m < 64; m <<= 1) ss += __shfl_xor(ss, m);
    const float rstd = rsqrtf(ss * (1.f / 1024.f) + EPS);
    if (s != scur) { scur = s;
#pragma unroll
      for (int i = 0; i < 4; ++i) { const int c = i * 256 + lane * 4;
        const f32x4 g = *(const f32x4*)(p.norm_gain + c), sh = *(const f32x4*)(mod + s * 3072 + c), sc = *(const f32x4*)(mod + s * 3072 + 1024 + c);
        ca[i] = g * (1.f + sc); cb[i] = sh; } }
#pragma unroll
    for (int i = 0; i < 4; ++i) { const int c = i * 256 + lane * 4;
      const f32x4 h = v[i] * rstd * ca[i] + cb[i];
      u32x2 w; w.x = cvtpk(h[0], h[1]); w.y = cvtpk(h[2], h[3]); *(u32x2*)(hdst + (size_t)row * DM + c) = w; }
    if constexpr (WITH_OGN) {
      const bf16_t* of = (const bf16_t*)p.out + (size_t)row * DM; const bf16_t* ob = of + (size_t)NTOK * DM;
      bf16_t* ogn = (bf16_t*)(p.ws + OFF_OGN) + (size_t)row * DM;
#pragma unroll
      for (int i = 0; i < 2; ++i) { const int c = i * 512 + lane * 8;
        const u32x4 a = *(const u32x4*)(of + c), b = *(const u32x4*)(ob + c); float o[8]; float q = 0.f;
#pragma unroll
        for (int e = 0; e < 4; ++e) { o[2 * e] = bflo(a[e]) + bflo(b[e]); o[2 * e + 1] = bfhi(a[e]) + bfhi(b[e]); q += o[2 * e] * o[2 * e] + o[2 * e + 1] * o[2 * e + 1]; }
#pragma unroll
        for (int m = 1; m < 32; m <<= 1) q += __shfl_xor(q, m);
        const float r = rsqrtf(q * (1.f / 256.f) + EPS);
        const f32x4 g0 = gg0, g1 = gg1;
        u32x4 w; w.x = cvtpk(o[0] * r * g0[0], o[1] * r * g0[1]); w.y = cvtpk(o[2] * r * g0[2], o[3] * r * g0[3]);
        w.z = cvtpk(o[4] * r * g1[0], o[5] * r * g1[1]); w.w = cvtpk(o[6] * r * g1[2], o[7] * r * g1[3]);
        *(u32x4*)(ogn + c) = w; }
    }
  }
}

__device__ __forceinline__ int gsw(int row, int ch) { return row * 128 + ((ch ^ ((row >> 1) & 7)) << 4); }
template <bool SWAP>
__device__ __forceinline__ void gemm_tile(const bf16_t* __restrict__ A, int lda, const bf16_t* __restrict__ Bt, int ldb, int K, char* lds, f32x16 (&acc)[2][2]) {
  int tid_ = threadIdx.x; asm volatile("" : "+v"(tid_));
  const int tid = tid_, lane = tid & 63, wid = tid >> 6, wm = wid >> 1, wn = wid & 1, c32 = lane & 31, hi = lane >> 5;
  const int srow = tid >> 3, sch = tid & 7;
  const bf16_t* ga = A + (size_t)srow * lda + sch * 8; const bf16_t* gb = Bt + (size_t)srow * ldb + sch * 8;
  bf16x8 ra[4], rb[2];
  const int nk = K >> 6;
#define G_LOAD(kt) do { _Pragma("unroll") for (int i = 0; i < 4; ++i) ra[i] = *(const bf16x8*)(ga + (size_t)(64 * i) * lda + (kt) * 64); \
    _Pragma("unroll") for (int i = 0; i < 2; ++i) rb[i] = *(const bf16x8*)(gb + (size_t)(64 * i) * ldb + (kt) * 64); } while (0)
#define G_WRITE(buf) do { char* sA_ = lds + (buf) * 49152; char* sB_ = sA_ + 32768; \
    _Pragma("unroll") for (int i = 0; i < 4; ++i) *(bf16x8*)(sA_ + gsw(srow + 64 * i, sch)) = ra[i]; \
    _Pragma("unroll") for (int i = 0; i < 2; ++i) *(bf16x8*)(sB_ + gsw(srow + 64 * i, sch)) = rb[i]; } while (0)
  G_LOAD(0);
  __syncthreads();
  G_WRITE(0);
  if (nk > 1) G_LOAD(1);
  __syncthreads();
  for (int kt = 0; kt < nk; ++kt) {
    const int cur = kt & 1;
    const char* sA = lds + cur * 49152; const char* sB = sA + 32768;
#define G_FRAG(FA, FB, ks) do { _Pragma("unroll") for (int i = 0; i < 2; ++i) { FA[i] = *(const bf16x8*)(sA + gsw(wm * 64 + i * 32 + c32, (ks) * 2 + hi)); FB[i] = *(const bf16x8*)(sB + gsw(wn * 64 + i * 32 + c32, (ks) * 2 + hi)); } } while (0)
#define G_MMA4(FA, FB) do { _Pragma("unroll") for (int mi = 0; mi < 2; ++mi) _Pragma("unroll") for (int ni = 0; ni < 2; ++ni) \
      acc[mi][ni] = SWAP ? __builtin_amdgcn_mfma_f32_32x32x16_bf16(FB[ni], FA[mi], acc[mi][ni], 0, 0, 0) : __builtin_amdgcn_mfma_f32_32x32x16_bf16(FA[mi], FB[ni], acc[mi][ni], 0, 0, 0); } while (0)
    { bf16x8 fa0[2], fb0[2], fa1[2], fb1[2];
      G_FRAG(fa0, fb0, 0); G_FRAG(fa1, fb1, 1); __builtin_amdgcn_sched_barrier(0);
      G_MMA4(fa0, fb0); __builtin_amdgcn_sched_barrier(0);
      if (kt + 1 < nk) { G_WRITE(cur ^ 1); if (kt + 2 < nk) G_LOAD(kt + 2); }
      G_FRAG(fa0, fb0, 2); __builtin_amdgcn_sched_barrier(0);
      G_MMA4(fa1, fb1); __builtin_amdgcn_sched_barrier(0);
      G_FRAG(fa1, fb1, 3); __builtin_amdgcn_sched_barrier(0);
      G_MMA4(fa0, fb0); __builtin_amdgcn_sched_barrier(0);
      G_MMA4(fa1, fb1); }
#undef G_FRAG
#undef G_MMA4
    __syncthreads();
  }
#undef G_LOAD
#undef G_WRITE
}
__device__ __forceinline__ void zero_acc(f32x16 (&acc)[2][2]) {
#pragma unroll
  for (int a = 0; a < 2; ++a)
#pragma unroll
    for (int b = 0; b < 2; ++b)
#pragma unroll
      for (int r = 0; r < 16; ++r) acc[a][b][r] = 0.f;
}
__device__ __forceinline__ void store_rows_bf16(const f32x16 (&acc)[2][2], bf16_t* dst, int ld, int tok0, int col0, int c32, int hi) {
#pragma unroll
  for (int mi = 0; mi < 2; ++mi)
#pragma unroll
    for (int ni = 0; ni < 2; ++ni)
#pragma unroll
      for (int g = 0; g < 4; g += 2) { const f32x16& v = acc[mi][ni];
        const unsigned x0 = cvtpk(v[4 * g], v[4 * g + 1]), x1 = cvtpk(v[4 * g + 2], v[4 * g + 3]), y0 = cvtpk(v[4 * g + 4], v[4 * g + 5]), y1 = cvtpk(v[4 * g + 6], v[4 * g + 7]);
        auto r0 = __builtin_amdgcn_permlane32_swap(x0, y0, false, false); auto r1 = __builtin_amdgcn_permlane32_swap(x1, y1, false, false);
        const u32x4 w = {r0[0], r1[0], r0[1], r1[1]};
        *(u32x4*)(dst + (size_t)(tok0 + mi * 32 + c32) * ld + col0 + ni * 32 + 8 * (g + hi)) = w; }
}

__device__ __forceinline__ bool patch_tile(int r, int NT, int& mt, int& nt) {
  const int nb = gridDim.x, per = nb >> 3, b = blockIdx.x;
  const int t = (nb & 7) ? r * nb + b : r * nb + (b & 7) * per + (b >> 3);
  if (t >= (NTOK / 256) * NT) return false;
  const int gsz = 4 * NT, grp = t / gsz, rem = t - grp * gsz; nt = rem >> 2; mt = grp * 4 + (rem & 3); return true;
}
__device__ NOINL void phase1(const Params& p) {
  char* lds = g_lds;
  int tid_ = threadIdx.x; asm volatile("" : "+v"(tid_));
  const int tid = tid_, lane = tid & 63, wid = tid >> 6, wm = wid >> 1, wn = wid & 1, c32 = lane & 31, hi = lane >> 5;
  const bf16_t* H = (const bf16_t*)((const char*)p.out + SZ_FULL);
  const bf16_t* W = (const bf16_t*)(p.ws + OFF_WP1);
  const f32x2* ropeHi = (const f32x2*)(p.ws + OFF_ROPE); const f32x2* ropeLo = ropeHi + 4096;
  constexpr int NT = NP1 / 128;
  for (int rr = 0;; ++rr) {
    int mt, nt; if (!patch_tile(rr, NT, mt, nt)) break;
    const int m0 = mt * 256, n0 = nt * 128;
    f32x16 acc[2][2]; zero_acc(acc);
    const int rw = m0 + wm * 64, cw = n0 + wn * 64;
    if (nt >= 8 && nt < 16) {
      gemm_tile<false>(H + (size_t)m0 * DM, DM, W + (size_t)n0 * DM, DM, DM, lds, acc);
      bf16_t* dst = (bf16_t*)(p.ws + OFF_GV); const int cb = cw - 1024;
#pragma unroll
      for (int mi = 0; mi < 2; ++mi)
#pragma unroll
        for (int ni = 0; ni < 2; ++ni)
#pragma unroll
          for (int q = 0; q < 4; ++q) { u32x2 w; w.x = cvtpk(acc[mi][ni][4 * q], acc[mi][ni][4 * q + 1]); w.y = cvtpk(acc[mi][ni][4 * q + 2], acc[mi][ni][4 * q + 3]);
            *(u32x2*)(dst + (size_t)(cb + ni * 32 + c32) * NTOK + rw + mi * 32 + 8 * q + 4 * hi) = w; }
      continue;
    }
    gemm_tile<true>(H + (size_t)m0 * DM, DM, W + (size_t)n0 * DM, DM, DM, lds, acc);
    if (nt < 8) {
      if (nt < 4) {
#pragma unroll
        for (int mi = 0; mi < 2; ++mi)
#pragma unroll
          for (int ni = 0; ni < 2; ++ni) acc[mi][ni] = acc[mi][ni] * 0.08838834764831845f;
        store_rows_bf16(acc, (bf16_t*)(p.ws + OFF_GQ), 512, rw, cw, c32, hi);
      } else store_rows_bf16(acc, (bf16_t*)(p.ws + OFF_GK), 512, rw, cw - 512, c32, hi);
    } else if (nt < 32) {
      const int pos0 = m0 < LP ? m0 : (m0 & (LS - 1));
      const float qsc = nt < 24 ? 0.18033688011112042f : 1.f;
      const f32x2* thp = ropeHi + ((pos0 >> 7) + (wm >> 1)) * 32 + 4 * hi;
#pragma unroll
      for (int mi = 0; mi < 2; ++mi) { const f32x2* tlp = ropeLo + ((wm * 64 + mi * 32 + c32) & 127) * 32 + 4 * hi;
#pragma unroll
        for (int g = 0; g < 4; ++g) { const f32x4 ta = *(const f32x4*)(thp + 8 * g), tb = *(const f32x4*)(thp + 8 * g + 2), la = *(const f32x4*)(tlp + 8 * g), lb = *(const f32x4*)(tlp + 8 * g + 2);
          const float thx[4] = {ta[0], ta[2], tb[0], tb[2]}, thy[4] = {ta[1], ta[3], tb[1], tb[3]}, tlx[4] = {la[0], la[2], lb[0], lb[2]}, tly[4] = {la[1], la[3], lb[1], lb[3]};
#pragma unroll
          for (int e = 0; e < 4; ++e) { const int r = 4 * g + e; const float c = thx[e] * tlx[e] - thy[e] * tly[e], s = thy[e] * tlx[e] + thx[e] * tly[e];
            const float x1 = acc[mi][0][r] * qsc, x2 = acc[mi][1][r] * qsc; acc[mi][0][r] = x1 * c - x2 * s; acc[mi][1][r] = x1 * s + x2 * c; } } }
      { const int cb = cw - (nt < 24 ? 2048 : 3072);
        store_rows_bf16(acc, (bf16_t*)(p.ws + (nt < 24 ? OFF_DQ : OFF_DK)) + (size_t)(cb >> 7) * NTOK * 128, 128, rw, cb & 127, c32, hi); }
    } else if (nt < 40) {
      { const int cb = cw - 4096; store_rows_bf16(acc, (bf16_t*)(p.ws + OFF_DV) + (size_t)(cb >> 7) * NTOK * 128, 128, rw, cb & 127, c32, hi); }
    } else if (wn == 0) {
      float* dst = (float*)(p.ws + OFF_LOW);
#pragma unroll
      for (int mi = 0; mi < 2; ++mi)
#pragma unroll
        for (int g = 0; g < 4; ++g) *(f32x4*)(dst + (size_t)(rw + mi * 32 + c32) * 32 + 8 * g + 4 * hi) = (f32x4){acc[mi][0][4 * g], acc[mi][0][4 * g + 1], acc[mi][0][4 * g + 2], acc[mi][0][4 * g + 3]};
    }
  }
}

constexpr int GQT = 0, GKT = 17408, GKH = 34816, GVT = 53248, GSC = 90112, GLWA = 99328, GDEC = 104448, GLA_LDS = 104960;
constexpr int QROW = 272, HROW = 144, LROW = 80;
__device__ __forceinline__ unsigned rot16(unsigned x) { return (x >> 16) | (x << 16); }

__device__ __forceinline__ void gla_item(const Params& p, int s, int hh, int dir, char* lds) {
  int tid_ = threadIdx.x; asm volatile("" : "+v"(tid_));
  const int tid = tid_, lane = tid & 63, wid = __builtin_amdgcn_readfirstlane(tid >> 6), n16 = lane & 15, g4 = lane >> 4;
  const int base = seq_base(s), L = seq_len(s), nchunk = L >> 6;
  const bf16_t* GQ = (const bf16_t*)(p.ws + OFF_GQ) + hh * 128; const bf16_t* GK = (const bf16_t*)(p.ws + OFF_GK) + hh * 128;
  const bf16_t* GVg = (const bf16_t*)(p.ws + OFF_GV) + (size_t)(hh * 256) * NTOK; const float* LOW = (const float*)(p.ws + OFF_LOW) + dir * 16;
  bf16_t* OUT = (bf16_t*)p.out + (size_t)dir * NTOK * DM + hh * 256 + wid * 32;
  bf16x8 B1, B2; float ba;
  { const int d = hh * 128 + wid * 16 + n16; float wh[8], wl[8];
#pragma unroll
    for (int e = 0; e < 8; ++e) { const float w = p.w_alpha[(size_t)(dir * 16 + (g4 & 1) * 8 + e) * 512 + d]; const float h = bf2f(f2bf(w)); wh[e] = h; wl[e] = (g4 < 2) ? (w - h) : 0.f; }
    u32x4 a = {cvtpk(wh[0], wh[1]), cvtpk(wh[2], wh[3]), cvtpk(wh[4], wh[5]), cvtpk(wh[6], wh[7])}; B1 = *(bf16x8*)&a;
    u32x4 c = {cvtpk(wl[0], wl[1]), cvtpk(wl[2], wl[3]), cvtpk(wl[4], wl[5]), cvtpk(wl[6], wl[7])}; B2 = *(bf16x8*)&c;
    ba = p.b_alpha[dir * 512 + d]; }
  f32x4 S[2][8];
#pragma unroll
  for (int nb = 0; nb < 2; ++nb)
#pragma unroll
    for (int b = 0; b < 8; ++b) S[nb][b] = (f32x4){0.f, 0.f, 0.f, 0.f};
  bf16x8 rq[2], rk[2]; u32x4 rv[4]; f32x4 rl = {0.f, 0.f, 0.f, 0.f};
#define GLA_TOK0(c) (dir == 0 ? (c) * 64 : L - 64 * ((c) + 1))
#define GLA_LOAD(c) do { const size_t r0 = (size_t)(base + GLA_TOK0(c)); \
    _Pragma("unroll") for (int i = 0; i < 2; ++i) { const int id = tid + NTHR * i, j = id >> 4, ch = id & 15; rq[i] = *(const bf16x8*)(GQ + (r0 + j) * 512 + ch * 8); rk[i] = *(const bf16x8*)(GK + (r0 + j) * 512 + ch * 8); } \
    _Pragma("unroll") for (int i = 0; i < 4; ++i) { const int id = tid + NTHR * i, e = id >> 3, jq = id & 7; rv[i] = *(const u32x4*)(GVg + (size_t)e * NTOK + r0 + jq * 8); } \
    if (tid < 256) { const int j = tid >> 2, pt = tid & 3; rl = *(const f32x4*)(LOW + (r0 + j) * 32 + pt * 4); } } while (0)
  GLA_LOAD(0);
  for (int c = 0; c < nchunk; ++c) {
    __syncthreads();
#pragma unroll
    for (int i = 0; i < 2; ++i) { const int id = tid + NTHR * i, jm = id >> 4, ch = id & 15, j = dir ? 63 - jm : jm;
      *(bf16x8*)(lds + GQT + j * QROW + ch * 16) = rq[i]; *(bf16x8*)(lds + GKT + j * QROW + ch * 16) = rk[i]; }
#pragma unroll
    for (int i = 0; i < 4; ++i) { const int id = tid + NTHR * i, e = id >> 3, jq = id & 7; u32x4 w = rv[i];
      if (dir) { w = (u32x4){rot16(rv[i].w), rot16(rv[i].z), rot16(rv[i].y), rot16(rv[i].x)}; }
      *(u32x4*)(lds + GVT + e * HROW + (dir ? 7 - jq : jq) * 16) = w; }
    if (tid < 256) { const int jm = tid >> 2, pt = tid & 3, j = dir ? 63 - jm : jm;
      const float h0 = bf2f(f2bf(rl[0])), h1 = bf2f(f2bf(rl[1])), h2 = bf2f(f2bf(rl[2])), h3 = bf2f(f2bf(rl[3]));
      u32x2 wh = {cvtpk(h0, h1), cvtpk(h2, h3)}, wl = {cvtpk(rl[0] - h0, rl[1] - h1), cvtpk(rl[2] - h2, rl[3] - h3)};
      *(u32x2*)(lds + GLWA + j * LROW + pt * 8) = wh; *(u32x2*)(lds + GLWA + j * LROW + 32 + pt * 8) = wl; }
    __syncthreads();
    if (c + 1 < nchunk) GLA_LOAD(c + 1);
    {
      float bb[16]; float carry = 0.f;
#pragma unroll
      for (int jb = 0; jb < 4; ++jb) {
        const bf16x8 la = *(const bf16x8*)(lds + GLWA + (jb * 16 + n16) * LROW + g4 * 16);
        f32x4 x = {ba, ba, ba, ba};
        x = __builtin_amdgcn_mfma_f32_16x16x32_bf16(la, B1, x, 0, 0, 0); x = __builtin_amdgcn_mfma_f32_16x16x32_bf16(la, B2, x, 0, 0, 0);
        float sc4[4]; float run = 0.f;
#pragma unroll
        for (int r = 0; r < 4; ++r) { const float lg = x[r]; run += (fminf(lg, 0.f) - __logf(1.f + __expf(-fabsf(lg)))) * 0.0625f; sc4[r] = run; }
        float inc = run; float u = __shfl_up(inc, 16); if (g4 >= 1) inc += u; u = __shfl_up(inc, 32); if (g4 >= 2) inc += u;
        const float ex = carry + (inc - run);
#pragma unroll
        for (int r = 0; r < 4; ++r) bb[jb * 4 + r] = ex + sc4[r];
        carry += __shfl(inc, 48 + n16);
      }
      const float eblast = __expf(carry); const int d = wid * 16 + n16;
      if (g4 == 0) ((float*)(lds + GDEC))[d] = eblast;
#pragma unroll
      for (int jb = 0; jb < 4; ++jb) { float kh[4];
#pragma unroll
        for (int r = 0; r < 4; ++r) { const int j = jb * 16 + g4 * 4 + r; const float b = bb[jb * 4 + r], e1 = __expf(b), e2 = __expf(-b);
          bf16_t* qp = (bf16_t*)(lds + GQT + j * QROW + d * 2); bf16_t* kp = (bf16_t*)(lds + GKT + j * QROW + d * 2);
          const float qv = bf2f(*qp), kv = bf2f(*kp); *qp = f2bf(qv * e1); const float kt = kv * e2; *kp = f2bf(kt); kh[r] = kt * eblast; }
        u32x2 w = {cvtpk(kh[0], kh[1]), cvtpk(kh[2], kh[3])};
        *(u32x2*)(lds + GKH + d * HROW + (jb * 16 + g4 * 4) * 2) = w; }
    }
    __syncthreads();
    {
      const int ib = wid >> 1;
      bf16x8 aq[4];
#pragma unroll
      for (int ks = 0; ks < 4; ++ks) aq[ks] = *(const bf16x8*)(lds + GQT + (ib * 16 + n16) * QROW + (ks * 32 + g4 * 8) * 2);
#pragma unroll
      for (int jj = 0; jj < 2; ++jj) { const int jb = (wid & 1) * 2 + jj; f32x4 a = {0.f, 0.f, 0.f, 0.f};
        if (jb <= ib) {
#pragma unroll
          for (int ks = 0; ks < 4; ++ks) { const bf16x8 bk = *(const bf16x8*)(lds + GKT + (jb * 16 + n16) * QROW + (ks * 32 + g4 * 8) * 2);
            a = __builtin_amdgcn_mfma_f32_16x16x32_bf16(aq[ks], bk, a, 0, 0, 0); } }
#pragma unroll
        for (int r = 0; r < 4; ++r) { float v = a[r]; if (jb == ib && n16 > g4 * 4 + r) v = 0.f;
          *(bf16_t*)(lds + GSC + (ib * 16 + g4 * 4 + r) * HROW + (jb * 16 + n16) * 2) = f2bf(v); } }
    }
    __syncthreads();
    {
      bf16x8 sb[2][4];
#pragma unroll
      for (int nb = 0; nb < 2; ++nb)
#pragma unroll
        for (int ks = 0; ks < 4; ++ks) { u32x4 w; w.x = cvtpk(S[nb][2 * ks][0], S[nb][2 * ks][1]); w.y = cvtpk(S[nb][2 * ks][2], S[nb][2 * ks][3]);
          w.z = cvtpk(S[nb][2 * ks + 1][0], S[nb][2 * ks + 1][1]); w.w = cvtpk(S[nb][2 * ks + 1][2], S[nb][2 * ks + 1][3]); sb[nb][ks] = *(bf16x8*)&w; }
      bf16x8 vf[2][2];
#pragma unroll
      for (int nb = 0; nb < 2; ++nb)
#pragma unroll
        for (int k2 = 0; k2 < 2; ++k2) vf[nb][k2] = *(const bf16x8*)(lds + GVT + (wid * 32 + nb * 16 + n16) * HROW + (k2 * 32 + g4 * 8) * 2);
      const size_t r0 = (size_t)(base + GLA_TOK0(c));
#pragma unroll
      for (int ib = 0; ib < 4; ++ib) { f32x4 o[2] = {{0.f, 0.f, 0.f, 0.f}, {0.f, 0.f, 0.f, 0.f}};
#pragma unroll
        for (int ks = 0; ks < 4; ++ks) { const char* qp = lds + GQT + (ib * 16 + n16) * QROW + (ks * 32 + g4 * 4) * 2;
          const u32x2 lo = *(const u32x2*)qp, hi2 = *(const u32x2*)(qp + 32); u32x4 w = {lo.x, lo.y, hi2.x, hi2.y}; const bf16x8 a = *(bf16x8*)&w;
          o[0] = __builtin_amdgcn_mfma_f32_16x16x32_bf16(sb[0][ks], a, o[0], 0, 0, 0); o[1] = __builtin_amdgcn_mfma_f32_16x16x32_bf16(sb[1][ks], a, o[1], 0, 0, 0); }
#pragma unroll
        for (int k2 = 0; k2 < 2; ++k2) { const bf16x8 a = *(const bf16x8*)(lds + GSC + (ib * 16 + n16) * HROW + (k2 * 32 + g4 * 8) * 2);
          o[0] = __builtin_amdgcn_mfma_f32_16x16x32_bf16(vf[0][k2], a, o[0], 0, 0, 0); o[1] = __builtin_amdgcn_mfma_f32_16x16x32_bf16(vf[1][k2], a, o[1], 0, 0, 0); }
        { const int j = ib * 16 + n16; const size_t row = r0 + (dir ? 63 - j : j);
          u32x2 w0 = {cvtpk(o[0][0], o[0][1]), cvtpk(o[0][2], o[0][3])}, w1 = {cvtpk(o[1][0], o[1][1]), cvtpk(o[1][2], o[1][3])};
          *(u32x2*)(OUT + row * DM + g4 * 4) = w0; *(u32x2*)(OUT + row * DM + 16 + g4 * 4) = w1; } }
      const float* dec = (const float*)(lds + GDEC);
#pragma unroll
      for (int b = 0; b < 8; ++b) { const f32x4 dc = *(const f32x4*)(dec + b * 16 + g4 * 4);
        S[0][b] = S[0][b] * dc; S[1][b] = S[1][b] * dc;
#pragma unroll
        for (int k2 = 0; k2 < 2; ++k2) { const bf16x8 a = *(const bf16x8*)(lds + GKH + (b * 16 + n16) * HROW + (k2 * 32 + g4 * 8) * 2);
          S[0][b] = __builtin_amdgcn_mfma_f32_16x16x32_bf16(a, vf[0][k2], S[0][b], 0, 0, 0); S[1][b] = __builtin_amdgcn_mfma_f32_16x16x32_bf16(a, vf[1][k2], S[1][b], 0, 0, 0); } }
    }
  }
  __syncthreads();
#undef GLA_LOAD
#undef GLA_TOK0
}

constexpr int SHM_V = 16384, SHM_K = 16384, ATT_LDS = 2 * SHM_V + 2 * SHM_K + 8 * 512;
#define KSWZ(row, colB) ((row) * 256 + ((colB) ^ (((row) & 15) << 4)))
#define SBAR() __builtin_amdgcn_sched_barrier(0)
constexpr float ATT_SCALE = 0.125f, ATT_THR = 8.f;
constexpr float ATT_THR2 = ATT_THR * 1.4426950408889634f;
__device__ __forceinline__ void partialSM(f32x16& p0, f32x16& p1, float& m_reg, float& alpha, f32x16& negv, bool first) {
  float tmax = p0[0];
#pragma unroll
  for (int r = 1; r < 16; ++r) tmax = fmaxf(tmax, p0[r]);
#pragma unroll
  for (int r = 0; r < 16; ++r) tmax = fmaxf(tmax, p1[r]);
  { auto rr = __builtin_amdgcn_permlane32_swap(__float_as_uint(tmax), __float_as_uint(tmax), false, false); tmax = fmaxf(__uint_as_float(rr[0]), __uint_as_float(rr[1])); }
  alpha = 1.f;
  if (__builtin_expect(first || !__all(tmax <= ATT_THR2), 0)) {
    const float d = first ? tmax : fmaxf(tmax, 0.f);
    if (!first) alpha = __builtin_amdgcn_exp2f(-d);
    m_reg += d;
#pragma unroll
    for (int r = 0; r < 16; ++r) { p0[r] -= d; p1[r] -= d; negv[r] = -m_reg; }
  }
#pragma unroll
  for (int r = 0; r < 16; ++r) { p0[r] = __builtin_amdgcn_exp2f(p0[r]); p1[r] = __builtin_amdgcn_exp2f(p1[r]); }
}
__device__ __forceinline__ void finishSM(const f32x16& p0, const f32x16& p1, float alpha, float& l_reg, bf16x8& pa0, bf16x8& pa1, bf16x8& pa2, bf16x8& pa3) {
  float ps = 0.f;
#pragma unroll
  for (int r = 0; r < 16; ++r) ps += p0[r] + p1[r];
  { auto rr = __builtin_amdgcn_permlane32_swap(__float_as_uint(ps), __float_as_uint(ps), false, false); ps = __uint_as_float(rr[0]) + __uint_as_float(rr[1]); }
  l_reg = l_reg * alpha + ps;
#define PK4(P, BASE, OUTV) do { unsigned a0 = cvtpk(P[BASE + 0], P[BASE + 1]), a1 = cvtpk(P[BASE + 2], P[BASE + 3]);   \
    unsigned b0 = cvtpk(P[BASE + 4], P[BASE + 5]), b1 = cvtpk(P[BASE + 6], P[BASE + 7]);                              \
    auto r0 = __builtin_amdgcn_permlane32_swap(a0, b0, false, false); auto r1 = __builtin_amdgcn_permlane32_swap(a1, b1, false, false); \
    u32x4 w = {r0[0], r1[0], r0[1], r1[1]}; OUTV = *reinterpret_cast<bf16x8*>(&w); } while (0)
  PK4(p0, 0, pa0); PK4(p0, 8, pa1); PK4(p1, 0, pa2); PK4(p1, 8, pa3);
#undef PK4
}
__device__ __forceinline__ void qkt(f32x16& p0, f32x16& p1, const char* Ks, const bf16x8* qr, int r32, int hi, int z, const f32x16& negv) {
  p0 = negv; p1 = negv;
#pragma unroll
  for (int d0 = 0; d0 < 4; ++d0) { const int cb = ((z * 4 + d0) * 16 + hi * 8) * 2;
    const bf16x8 b0 = *reinterpret_cast<const bf16x8*>(Ks + KSWZ(r32, cb)); const bf16x8 b1 = *reinterpret_cast<const bf16x8*>(Ks + KSWZ(32 + r32, cb));
    p0 = __builtin_amdgcn_mfma_f32_32x32x16_bf16(b0, qr[d0], p0, 0, 0, 0); p1 = __builtin_amdgcn_mfma_f32_32x32x16_bf16(b1, qr[d0], p1, 0, 0, 0); }
}
__device__ __forceinline__ int v_st(int k, int c) { const int kk = (k & ~0xC) | ((k & 4) << 1) | ((k & 8) >> 1); return ((kk >> 3) * 4 + (c >> 5)) * 512 + ((kk & 7) * 32 + (c & 31)) * 2; }
__device__ __forceinline__ int v_rd_base(int lane) { return ((lane & 3) << 3) | (((lane >> 2) & 3) << 6) | (((lane >> 4) & 1) << 5) | (((lane >> 5) & 1) << 8); }
constexpr int v_rd_off(int d0, int ks, int half) { return d0 * 512 + ks * 4096 + half * 2048; }
template <int OFF> __device__ __forceinline__ s16x4 tr_read(int vb) { s16x4 r; asm volatile("ds_read_b64_tr_b16 %0, %1 offset:%2" : "=&v"(r) : "v"(vb), "i"(OFF) : "memory"); return r; }
struct VFrag { s16x4 l0, h0, l1, h1, l2, h2, l3, h3; };
template <int D0> __device__ __forceinline__ void pv_read(VFrag& f, int vb) {
  f.l0 = tr_read<v_rd_off(D0, 0, 0)>(vb); f.h0 = tr_read<v_rd_off(D0, 0, 1)>(vb); f.l1 = tr_read<v_rd_off(D0, 1, 0)>(vb); f.h1 = tr_read<v_rd_off(D0, 1, 1)>(vb);
  f.l2 = tr_read<v_rd_off(D0, 2, 0)>(vb); f.h2 = tr_read<v_rd_off(D0, 2, 1)>(vb); f.l3 = tr_read<v_rd_off(D0, 3, 0)>(vb); f.h3 = tr_read<v_rd_off(D0, 3, 1)>(vb);
}
__device__ __forceinline__ void pv_mma(f32x16& od, const VFrag& f, bf16x8 pa0, bf16x8 pa1, bf16x8 pa2, bf16x8 pa3) {
#define PKV(L, H) (bf16x8){L[0], L[1], L[2], L[3], H[0], H[1], H[2], H[3]}
  od = __builtin_amdgcn_mfma_f32_32x32x16_bf16(pa0, PKV(f.l0, f.h0), od, 0, 0, 0);
  od = __builtin_amdgcn_mfma_f32_32x32x16_bf16(pa1, PKV(f.l1, f.h1), od, 0, 0, 0);
  od = __builtin_amdgcn_mfma_f32_32x32x16_bf16(pa2, PKV(f.l2, f.h2), od, 0, 0, 0);
  od = __builtin_amdgcn_mfma_f32_32x32x16_bf16(pa3, PKV(f.l3, f.h3), od, 0, 0, 0);
#undef PKV
}
__device__ __forceinline__ void pv_d0(f32x16* o, int vb, bf16x8 pa0, bf16x8 pa1, bf16x8 pa2, bf16x8 pa3) {
  VFrag fa, fb;
  pv_read<0>(fa, vb);
  pv_read<1>(fb, vb); asm volatile("s_waitcnt lgkmcnt(8)" ::: "memory"); SBAR();
  pv_mma(o[0], fa, pa0, pa1, pa2, pa3); SBAR();
  pv_read<2>(fa, vb); asm volatile("s_waitcnt lgkmcnt(8)" ::: "memory"); SBAR();
  pv_mma(o[1], fb, pa0, pa1, pa2, pa3); SBAR();
  pv_read<3>(fb, vb); asm volatile("s_waitcnt lgkmcnt(8)" ::: "memory"); SBAR();
  pv_mma(o[2], fa, pa0, pa1, pa2, pa3); SBAR();
  asm volatile("s_waitcnt lgkmcnt(0)" ::: "memory"); SBAR();
  pv_mma(o[3], fb, pa0, pa1, pa2, pa3);
}

__device__ __forceinline__ void attn_item(const bf16_t* Qb, const bf16_t* Kh, const bf16_t* Vh, bf16_t* Ob, int seq, char* lds, float lam, const float* gain) {
  int tid_ = threadIdx.x; asm volatile("" : "+v"(tid_));
  const int tid = tid_, wid = __builtin_amdgcn_readfirstlane(tid >> 6), lane = tid & 63, r32 = lane & 31, hi = lane >> 5, qg = wid >> 1, z = wid & 1;
  char* V_lds = lds; char* K_lds = lds + 5 * SHM_V;
  float* wsf = (float*)(lds + 5 * SHM_V + 4 * SHM_K) + wid * 128; float* al_l = wsf; float* li = wsf + 32;
  float m = 0.f, l = 0.f; f32x16 o[4]; bf16x8 qr[4]; f32x16 negv;
#pragma unroll
  for (int r = 0; r < 16; ++r) negv[r] = 0.f;
#pragma unroll
  for (int d = 0; d < 4; ++d)
#pragma unroll
    for (int r = 0; r < 16; ++r) o[d][r] = 0.f;
  const bf16_t* Qw = Qb + (size_t)(qg * 32 + r32) * 128 + z * 64 + hi * 8;
#pragma unroll
  for (int d0 = 0; d0 < 4; ++d0) qr[d0] = *(const bf16x8*)(Qw + d0 * 16);
  const int vb0 = (int)(uintptr_t)V_lds + v_rd_base(lane);
  int koff[2], voff[2];
#pragma unroll
  for (int i = 0; i < 2; ++i) { const int row = wid * 8 + i * 4 + (lane >> 4), lc = (lane & 15) ^ (row & 15); koff[i] = row * 128 + lc * 8;
    const int u = wid * 128 + i * 64 + lane, st = u >> 5, wi = u & 31, kk = (st >> 2) * 8 + (wi >> 2), c = (st & 3) * 32 + (wi & 3) * 8;
    const int k = (kk & ~0xC) | ((kk & 4) << 1) | ((kk & 8) >> 1); voff[i] = k * 128 + c; }
#define DMA_TILE(t, kslot, vslot) do { const bf16_t* kp_ = Kh + (size_t)(t) * 8192; const bf16_t* vp_ = Vh + (size_t)(t) * 8192; \
    _Pragma("unroll") for (int i = 0; i < 2; ++i) __builtin_amdgcn_global_load_lds((const unsigned*)(kp_ + koff[i]), (unsigned*)(K_lds + (kslot) * SHM_K + (wid * 8 + i * 4) * 256), 16, 0, 0); \
    _Pragma("unroll") for (int i = 0; i < 2; ++i) __builtin_amdgcn_global_load_lds((const unsigned*)(vp_ + voff[i]), (unsigned*)(V_lds + (vslot) * SHM_V + (wid * 128 + i * 64) * 16), 16, 0, 0); } while (0)
#define RAW_BARRIER() do { asm volatile("s_waitcnt lgkmcnt(0)" ::: "memory"); __builtin_amdgcn_s_barrier(); asm volatile("" ::: "memory"); } while (0)
  const int NT = seq >> 6;
  const bool late = wid >= 4;
  bf16x8 pa0, pa1, pa2, pa3;
#define ATT_INTERVAL(j, kb, vcur, vprev, MID) do { \
    if (late && (j) > 0) { pv_d0(o, vb0 + (vprev) * SHM_V, pa0, pa1, pa2, pa3); SBAR(); } \
    { f32x16 p0, p1; float al; \
      qkt(p0, p1, K_lds + (kb) * SHM_K, qr, r32, hi, z, negv); \
      partialSM(p0, p1, m, al, negv, (j) == 0); \
      SBAR(); \
      if (__any(al < 1.f)) { if (hi == 0) al_l[r32] = al; asm volatile("s_waitcnt lgkmcnt(0)" ::: "memory"); \
        _Pragma("unroll") for (int r = 0; r < 16; ++r) { const float f = al_l[crow(r, hi)]; _Pragma("unroll") for (int d = 0; d < 4; ++d) o[d][r] *= f; } } \
      finishSM(p0, p1, al, l, pa0, pa1, pa2, pa3); SBAR(); MID; SBAR(); } \
    if (!late) { pv_d0(o, vb0 + (vcur) * SHM_V, pa0, pa1, pa2, pa3); SBAR(); } } while (0)
  __syncthreads();
  DMA_TILE(0, 0, 0); DMA_TILE(1, 1, 1); DMA_TILE(2, 2, 2);
  asm volatile("s_waitcnt vmcnt(8)" ::: "memory"); RAW_BARRIER();
  int vcur = 0, vprev = 4, vis = 3;
  for (int j = 0; j < NT; ++j) {
    SBAR();
    ATT_INTERVAL(j, j & 3, vcur, vprev, { if (j + 3 < NT) DMA_TILE(j + 3, (j + 3) & 3, vis); });
    if (j + 3 < NT) asm volatile("s_waitcnt vmcnt(8)" ::: "memory"); else if (j + 2 < NT) asm volatile("s_waitcnt vmcnt(4)" ::: "memory"); else asm volatile("s_waitcnt vmcnt(0)" ::: "memory");
    RAW_BARRIER();
    vprev = vcur; vcur = vcur == 4 ? 0 : vcur + 1; vis = vis == 4 ? 0 : vis + 1;
  }
#undef ATT_INTERVAL
  if (late) { pv_d0(o, vb0 + vprev * SHM_V, pa0, pa1, pa2, pa3); }
  __syncthreads();
  if (hi == 0) li[r32] = l;
  asm volatile("s_waitcnt lgkmcnt(0)" ::: "memory");
  float* xch = (float*)lds + qg * 4096;
  if (z == 1) {
#pragma unroll
    for (int r = 0; r < 16; ++r) { const int rr = crow(r, hi); const float f = lam / li[rr];
#pragma unroll
      for (int d = 0; d < 4; ++d) xch[rr * 128 + d * 32 + r32] = o[d][r] * f; }
  }
  __syncthreads();
  if (z == 0) {
    float g4v[4];
#pragma unroll
    for (int d = 0; d < 4; ++d) g4v[d] = gain[d * 32 + r32] * 0.8f;
#pragma unroll
    for (int r = 0; r < 16; ++r) { const int rr = crow(r, hi); const float i0 = 1.f / li[rr]; float q = 0.f;
#pragma unroll
      for (int d = 0; d < 4; ++d) { const float v = o[d][r] * i0 - xch[rr * 128 + d * 32 + r32]; o[d][r] = v; q += v * v; }
#pragma unroll
      for (int mm = 1; mm < 32; mm <<= 1) q += __shfl_xor(q, mm);
      const float rs = rsqrtf(q * (1.f / 128.f) + EPS);
      bf16_t* orow = Ob + (size_t)(qg * 32 + rr) * 128 + r32;
#pragma unroll
      for (int d = 0; d < 4; ++d) orow[d * 32] = f2bf(o[d][r] * rs * g4v[d]); }
  }
#undef DMA_TILE
#undef RAW_BARRIER
}

constexpr int XQ_GP = 1, XQ_AP = 128, XQ_GS = 8, XQ_AS = 256, XQ_ITEMS = XQ_GP + XQ_AP + XQ_GS + XQ_AS;
__device__ __forceinline__ unsigned xcc_id() { return (unsigned)__builtin_amdgcn_s_getreg((3 << 11) | 20) & 0xFu; }
__device__ NOINL void phase2(const Params& p) {
  char* lds = g_lds;
  unsigned* qctr = (unsigned*)(p.ws + OFF_MISC) + 64;
  const float lam = ((const float*)(p.ws + OFF_MISC))[0];
  int* slot = (int*)(lds + LDS_BYTES - 64);
  const int x0 = (int)(xcc_id() & 7u);
  for (int xi = 0; xi < 8; ++xi) {
    const int x = (x0 + xi) & 7;
    for (;;) {
      __syncthreads();
      if (threadIdx.x == 0) *slot = (int)atomicAdd(qctr + x * 32, 1u);
      __syncthreads();
      int it = *slot;
      if (it >= XQ_ITEMS) break;
      bool is_gla; int s, a1, a2;
      if (it < XQ_GP) { const int g = x * XQ_GP + it; is_gla = true; s = 0; a1 = g >> 1; a2 = g & 1; }
      else if ((it -= XQ_GP) < XQ_AP) { is_gla = false; s = 0; a1 = x; a2 = it; }
      else if ((it -= XQ_AP) < XQ_GS) { const int g = x * XQ_GS + it; is_gla = true; s = 1 + (g >> 3); const int r = g & 7; a1 = r >> 1; a2 = r & 1; }
      else { it -= XQ_GS; is_gla = false; s = 1 + (it >> 5); a1 = x; a2 = it & 31; }
      if (is_gla) gla_item(p, s, a1, a2, lds);
      else { const size_t sb = ((size_t)a1 * NTOK + seq_base(s)) * 128, qo = sb + (size_t)(a2 * 128) * 128;
        attn_item((const bf16_t*)(p.ws + OFF_DQ) + qo, (const bf16_t*)(p.ws + OFF_DK) + sb, (const bf16_t*)(p.ws + OFF_DV) + sb, (bf16_t*)(p.ws + OFF_DQ) + qo, seq_len(s), lds, lam, p.diff_norm_gain); }
    }
  }
}

__device__ NOINL void phase3a(const Params& p) {
  char* lds = g_lds;
  int tid_ = threadIdx.x; asm volatile("" : "+v"(tid_));
  const int tid = tid_, lane = tid & 63, wid = tid >> 6, wm = wid >> 1, wn = wid & 1, c32 = lane & 31, hi = lane >> 5;
  const bf16_t* H = (const bf16_t*)(p.ws + OFF_H3); const bf16_t* W = (const bf16_t*)(p.ws + OFF_WP3);
  constexpr int NT = 16;
  for (int rr = 0;; ++rr) {
    int mt, nt; if (!patch_tile(rr, NT, mt, nt)) break;
    const int m0 = mt * 256, n0 = nt * 128;
    f32x16 acc[2][2]; zero_acc(acc);
    gemm_tile<true>(H + (size_t)m0 * DM, DM, W + (size_t)n0 * DM, DM, DM, lds, acc);
    const int rw = m0 + wm * 64, cw = (n0 & 1023) + wn * 64, seg = nt >> 3;
    const bf16_t* src = (const bf16_t*)(p.ws + (seg == 0 ? OFF_OGN : OFF_DQ));
    bf16_t* dst = seg == 0 ? (bf16_t*)(p.ws + OFF_A2) : seg == 1 ? (bf16_t*)(p.ws + OFF_A3) : seg == 2 ? (bf16_t*)p.out : (bf16_t*)p.out + (size_t)NTOK * DM;
#pragma unroll
    for (int mi = 0; mi < 2; ++mi)
#pragma unroll
      for (int ni = 0; ni < 2; ++ni)
#pragma unroll
        for (int g = 0; g < 4; ++g) {
          if (seg < 2) { const int tok = rw + mi * 32 + c32, col = cw + ni * 32 + 8 * g + 4 * hi;
            const u32x2 sv = *(const u32x2*)(src + (seg == 0 ? (size_t)tok * DM + col : ((size_t)(col >> 7) * NTOK + tok) * 128 + (col & 127)));
            acc[mi][ni][4 * g] = bflo(sv.x) * siluf(acc[mi][ni][4 * g]); acc[mi][ni][4 * g + 1] = bfhi(sv.x) * siluf(acc[mi][ni][4 * g + 1]);
            acc[mi][ni][4 * g + 2] = bflo(sv.y) * siluf(acc[mi][ni][4 * g + 2]); acc[mi][ni][4 * g + 3] = bfhi(sv.y) * siluf(acc[mi][ni][4 * g + 3]); }
          else {
#pragma unroll
            for (int e = 0; e < 4; ++e) acc[mi][ni][4 * g + e] = sigmf(acc[mi][ni][4 * g + e]); } }
    store_rows_bf16(acc, dst, DM, rw, cw, c32, hi);
  }
}
__device__ NOINL void phase3bc(const Params& p) {
  char* lds = g_lds;
  int tid_ = threadIdx.x; asm volatile("" : "+v"(tid_));
  const int tid = tid_, lane = tid & 63, wid = tid >> 6, wm = wid >> 1, wn = wid & 1, c32 = lane & 31, hi = lane >> 5;
  const bf16_t* A2 = (const bf16_t*)(p.ws + OFF_A2); const bf16_t* A3 = (const bf16_t*)(p.ws + OFF_A3);
  const bf16_t* SG = (const bf16_t*)p.out; const bf16_t* SD = SG + (size_t)NTOK * DM; bf16_t* MR = (bf16_t*)(p.ws + OFF_MRG);
  for (int rr = 0;; ++rr) {
    int mt, nt; if (!patch_tile(rr, 8, mt, nt)) break;
    const int m0 = mt * 256, n0 = nt * 128;
    const bf16_t* H3 = (const bf16_t*)(p.ws + OFF_H3) + (size_t)m0 * DM; const bf16_t* WM = (const bf16_t*)(p.ws + OFF_WP3) + (size_t)(2048 + n0) * DM;
    const int rw = m0 + wm * 64, cw = n0 + wn * 64;
    f32x16 a1[2][2]; unsigned tg[2][2][8], sd[2][2][8];
    zero_acc(a1); gemm_tile<true>(H3, DM, WM, DM, DM, lds, a1);
#pragma unroll
    for (int mi = 0; mi < 2; ++mi)
#pragma unroll
      for (int ni = 0; ni < 2; ++ni)
#pragma unroll
        for (int q = 0; q < 8; ++q) tg[mi][ni][q] = cvtpk(sigmf(a1[mi][ni][2 * q]), sigmf(a1[mi][ni][2 * q + 1]));
    zero_acc(a1); gemm_tile<true>(A2 + (size_t)m0 * DM, DM, (const bf16_t*)(p.ws + OFF_WG) + (size_t)n0 * DM, DM, DM, lds, a1);
#pragma unroll
    for (int mi = 0; mi < 2; ++mi)
#pragma unroll
      for (int ni = 0; ni < 2; ++ni)
#pragma unroll
        for (int q = 0; q < 8; ++q) tg[mi][ni][q] = cvtpk(bflo(tg[mi][ni][q]) * a1[mi][ni][2 * q], bfhi(tg[mi][ni][q]) * a1[mi][ni][2 * q + 1]);
    zero_acc(a1); gemm_tile<true>(H3, DM, WM + (size_t)1024 * DM, DM, DM, lds, a1);
#pragma unroll
    for (int mi = 0; mi < 2; ++mi)
#pragma unroll
      for (int ni = 0; ni < 2; ++ni)
#pragma unroll
        for (int q = 0; q < 8; ++q) sd[mi][ni][q] = cvtpk(sigmf(a1[mi][ni][2 * q]), sigmf(a1[mi][ni][2 * q + 1]));
    zero_acc(a1); gemm_tile<true>(A3 + (size_t)m0 * DM, DM, (const bf16_t*)(p.ws + OFF_WD) + (size_t)n0 * DM, DM, DM, lds, a1);
#pragma unroll
    for (int mi = 0; mi < 2; ++mi)
#pragma unroll
      for (int ni = 0; ni < 2; ++ni)
#pragma unroll
        for (int q = 0; q < 8; ++q) { a1[mi][ni][2 * q] = bflo(tg[mi][ni][q]) + bflo(sd[mi][ni][q]) * a1[mi][ni][2 * q]; a1[mi][ni][2 * q + 1] = bfhi(tg[mi][ni][q]) + bfhi(sd[mi][ni][q]) * a1[mi][ni][2 * q + 1]; }
    store_rows_bf16(a1, MR, DM, rw, cw, c32, hi);
  }
}
__device__ NOINL void phase3d(const Params& p) {
  char* lds = g_lds;
  int tid_ = threadIdx.x; asm volatile("" : "+v"(tid_));
  const int tid = tid_, lane = tid & 63, wid = tid >> 6, wm = wid >> 1, wn = wid & 1, c32 = lane & 31, hi = lane >> 5;
  const bf16_t* MR = (const bf16_t*)(p.ws + OFF_MRG); const float* mod = (const float*)(p.ws + OFF_MOD);
  for (int rr = 0;; ++rr) {
    int mt, nt; if (!patch_tile(rr, 8, mt, nt)) break;
    const int m0 = mt * 256, n0 = nt * 128;
    f32x16 acc[2][2]; zero_acc(acc);
    gemm_tile<true>(MR + (size_t)m0 * DM, DM, (const bf16_t*)(p.ws + OFF_WO) + (size_t)n0 * DM, DM, DM, lds, acc);
    const int rw = m0 + wm * 64, cw = n0 + wn * 64, s = seq_of_row(m0);
#pragma unroll
    for (int ni = 0; ni < 2; ++ni)
#pragma unroll
      for (int g = 0; g < 4; ++g) { const int col = cw + ni * 32 + 8 * g + 4 * hi; const f32x4 gt = *(const f32x4*)(mod + s * 3072 + 2048 + col);
#pragma unroll
        for (int mi = 0; mi < 2; ++mi) { const int row = rw + mi * 32 + c32; const f32x4 xv = *(const f32x4*)(xrow(p, row) + col);
          const f32x4 av = {acc[mi][ni][4 * g], acc[mi][ni][4 * g + 1], acc[mi][ni][4 * g + 2], acc[mi][ni][4 * g + 3]};
          *(f32x4*)(p.out + (size_t)row * DM + col) = xv + gt * av; } }
  }
}
__device__ NOINL void phase3e(const Params& p) {
  const int lane = threadIdx.x & 63, wid = threadIdx.x >> 6;
  f32x4 fg[4];
#pragma unroll
  for (int i = 0; i < 4; ++i) fg[i] = *(const f32x4*)(p.final_gain + i * 256 + lane * 4);
  for (int row = blockIdx.x * 8 + wid; row < NTOK; row += gridDim.x * 8) {
    float* o = p.out + (size_t)row * DM; f32x4 v[4]; float ss = 0.f;
#pragma unroll
    for (int i = 0; i < 4; ++i) { v[i] = *(const f32x4*)(o + i * 256 + lane * 4); ss += v[i][0] * v[i][0] + v[i][1] * v[i][1] + v[i][2] * v[i][2] + v[i][3] * v[i][3]; }
#pragma unroll
    for (int m = 1; m < 64; m <<= 1) ss += __shfl_xor(ss, m);
    const float rstd = rsqrtf(ss * (1.f / 1024.f) + EPS);
#pragma unroll
    for (int i = 0; i < 4; ++i) *(f32x4*)(o + i * 256 + lane * 4) = v[i] * rstd * fg[i];
  }
}

constexpr int NPHASE = 9;
__device__ __forceinline__ void gbar(unsigned* ctr, unsigned& epoch) {
  __syncthreads();
  if (threadIdx.x == 0) {
    epoch += gridDim.x;
    __builtin_amdgcn_fence(__ATOMIC_RELEASE, "agent");
    __hip_atomic_fetch_add(ctr, 1u, __ATOMIC_RELAXED, __HIP_MEMORY_SCOPE_AGENT);
    while (__hip_atomic_load(ctr, __ATOMIC_RELAXED, __HIP_MEMORY_SCOPE_AGENT) < epoch) __builtin_amdgcn_s_sleep(1);
    __builtin_amdgcn_fence(__ATOMIC_ACQUIRE, "agent");
  }
  __syncthreads();
}
template <int PB, int PE>
__global__ void __launch_bounds__(NTHR) mega(Params p) {
  char* lds = g_lds;
  unsigned epoch = 0; unsigned* bctr = (unsigned*)(p.ws + OFF_MISC) + 512;
#define PHASE(i, call) if constexpr (PB <= i && i < PE) { call; if constexpr (i + 1 < PE) { if constexpr (i == 0) cg::this_grid().sync(); else gbar(bctr, epoch); } }
  PHASE(0, phase0(p))
  PHASE(1, phase_h<false>(p, (bf16_t*)((char*)p.out + SZ_FULL)))
  PHASE(2, phase1(p))
  PHASE(3, phase2(p))
  PHASE(4, phase_h<true>(p, (bf16_t*)(p.ws + OFF_H3)))
  PHASE(5, phase3a(p))
  PHASE(6, phase3bc(p))
  PHASE(7, phase3d(p))
  PHASE(8, phase3e(p))
#undef PHASE
  (void)lds;
}

extern "C" void kernel_launch(void* const* d_in, const int* in_sizes, int n_in, void* d_out, int out_size, void* d_ws, size_t ws_size, hipStream_t stream) {
  if (n_in != 18 || out_size != NTOK * DM || ws_size < WS_NEED) { fprintf(stderr, "kernel_launch: unexpected shapes (n_in %d out %d ws %zu need %zu)\n", n_in, out_size, ws_size, WS_NEED); return; }
  Params p{};
  p.x_prompt = (const float*)d_in[0]; p.x_sample = (const float*)d_in[1]; p.c_prompt = (const float*)d_in[2]; p.c_sample = (const float*)d_in[3];
  p.w_ada = (const float*)d_in[4]; p.b_ada = (const float*)d_in[5]; p.norm_gain = (const float*)d_in[6]; p.w_in = (const float*)d_in[7];
  p.w_alpha = (const float*)d_in[8]; p.b_alpha = (const float*)d_in[9]; p.gla_norm_gain = (const float*)d_in[10]; p.lambda_q = (const float*)d_in[11];
  p.lambda_k = (const float*)d_in[12]; p.diff_norm_gain = (const float*)d_in[13]; p.w_bo_gla = (const float*)d_in[14]; p.w_bo_diff = (const float*)d_in[15];
  p.w_out = (const float*)d_in[16]; p.final_gain = (const float*)d_in[17]; p.out = (float*)d_out; p.ws = (char*)d_ws;
  static int grid_blocks = 0;
  if (!grid_blocks) { int dev = 0, cus = 0, per_cu = 0; hipGetDevice(&dev); hipDeviceGetAttribute(&cus, hipDeviceAttributeMultiprocessorCount, dev);
    hipOccupancyMaxActiveBlocksPerMultiprocessor(&per_cu, mega<0, NPHASE>, NTHR, 0); if (per_cu < 1) per_cu = 1; grid_blocks = cus * per_cu; }
#if COOP
  void* args[] = {&p};
  hipError_t e = hipLaunchCooperativeKernel((void*)mega<0, NPHASE>, dim3(grid_blocks), dim3(NTHR), args, 0, stream);
  if (e != hipSuccess) fprintf(stderr, "cooperative launch failed: %s (grid %d)\n", hipGetErrorString(e), grid_blocks);
#else
  hipLaunchKernelGGL((mega<0, 1>), dim3(grid_blocks), dim3(NTHR), 0, stream, p);
  hipLaunchKernelGGL((mega<1, 2>), dim3(grid_blocks), dim3(NTHR), 0, stream, p);
  hipLaunchKernelGGL((mega<2, 3>), dim3(grid_blocks), dim3(NTHR), 0, stream, p);
  hipLaunchKernelGGL((mega<3, 4>), dim3(grid_blocks), dim3(NTHR), 0, stream, p);
  hipLaunchKernelGGL((mega<4, 5>), dim3(grid_blocks), dim3(NTHR), 0, stream, p);
  hipLaunchKernelGGL((mega<5, 6>), dim3(grid_blocks), dim3(NTHR), 0, stream, p);
  hipLaunchKernelGGL((mega<6, 7>), dim3(grid_blocks), dim3(NTHR), 0, stream, p);
  hipLaunchKernelGGL((mega<7, 8>), dim3(grid_blocks), dim3(NTHR), 0, stream, p);
  hipLaunchKernelGGL((mega<8, 9>), dim3(grid_blocks), dim3(NTHR), 0, stream, p);
#endif
}
```
